# Optimizing an MI355X kernel written in HIP

```python
import math
import jax, jax.numpy as jnp
from jax import lax
import numpy as np

D_MODEL = 2048
BATCH = 1
SEQ = 8192
DEPTH = 1

POOL_WINDOWS = (2, 4, 8, 16)
POOL_GROUPS = len(POOL_WINDOWS)
POOL_GROUP_WIDTH = D_MODEL // 8
POOL_WIDTH = POOL_GROUPS * POOL_GROUP_WIDTH

ATTN_GROUPS = ((128, 1), (512, 4), (2048, 16))
HEADS_PER_GROUP = 4
N_ATTN_HEADS = HEADS_PER_GROUP * len(ATTN_GROUPS)
HEAD_DIM = 128
ATTN_WIDTH = N_ATTN_HEADS * HEAD_DIM
ATTN_OUT_WIDTH = HEADS_PER_GROUP * HEAD_DIM

N_BRANCHES = 2
IN_WIDTH = POOL_WIDTH + 3 * ATTN_WIDTH + N_BRANCHES * D_MODEL

D_FF = 5632
CONV_WIDTH = 3

RMS_EPS = 1e-6

kernel_name = "hybrid_pool_dilated_alibi_convffn_block"


def alibi_slopes(n_heads):
    return np.array([2.0 ** (-8.0 * (h + 1) / n_heads) for h in range(n_heads)], dtype=np.float32)


def rms_norm(x, g):
    xf = x.astype(jnp.float32)
    y = xf * lax.rsqrt(jnp.mean(xf * xf, axis=-1, keepdims=True) + RMS_EPS) * g.astype(jnp.float32)
    return y.astype(x.dtype)


def pool_mixer(u, w_lin, scale):
    B, S, _ = u.shape
    uf = u.astype(jnp.float32).reshape(B, S, POOL_GROUPS, POOL_GROUP_WIDTH)
    t = jnp.arange(S)
    outs = []
    for gi, w in enumerate(POOL_WINDOWS):
        ug = uf[:, :, gi]
        cs = jnp.cumsum(ug, axis=1)
        lag = jnp.pad(cs, ((0, 0), (w, 0), (0, 0)))[:, :S]
        cnt = jnp.minimum(t + 1, w).astype(jnp.float32)[None, :, None]
        outs.append((cs - lag) / cnt - ug)
    pooled = jnp.stack(outs, axis=2)
    y = jnp.einsum('bsgc,gce->bsge', pooled, w_lin.astype(jnp.float32))
    y = y.reshape(B, S, POOL_WIDTH) * scale.astype(jnp.float32)
    return y.astype(u.dtype)


def dilated_group_attention(q, k, v, slopes, window, dilation):
    B, S, H, Dh = q.shape
    span = window // dilation
    L = S // dilation
    nb = -(-L // span)
    Lp = nb * span
    N = B * dilation

    def to_sub(a):
        a = a.reshape(B, L, dilation, H, Dh).transpose(0, 2, 1, 3, 4).reshape(N, L, H, Dh)
        a = jnp.pad(a, ((0, 0), (0, Lp - L), (0, 0), (0, 0)))
        return a.reshape(N, nb, span, H, Dh)

    def with_prev(a):
        prev = jnp.pad(a, ((0, 0), (1, 0), (0, 0), (0, 0), (0, 0)))[:, :nb]
        return jnp.concatenate([prev, a], axis=2)

    qb = to_sub(q)
    kk = with_prev(to_sub(k))
    vv = with_prev(to_sub(v))

    s = jnp.einsum('nbqhd,nbkhd->nbhqk', qb, kk, preferred_element_type=jnp.float32) * (Dh ** -0.5)
    qi = jnp.arange(span)[:, None] + span
    ki = jnp.arange(2 * span)[None, :]
    j = qi - ki
    key_abs = (jnp.arange(nb) * span)[:, None] - span + jnp.arange(2 * span)[None, :]
    valid = ((j >= 0) & (j <= span))[None] & (key_abs >= 0)[:, None, :]
    bias = -slopes[:, None, None] * (j * dilation).astype(jnp.float32)[None]
    s = jnp.where(valid[None, :, None], s + bias[None, None], -jnp.inf)
    m = jnp.max(s, axis=-1, keepdims=True)
    p = jnp.exp(s - m)
    l = jnp.sum(p, axis=-1, keepdims=True)
    o = jnp.einsum('nbhqk,nbkhd->nbqhd', p, vv.astype(jnp.float32)) / jnp.swapaxes(l, 2, 3)
    lse = jnp.swapaxes((m + jnp.log(l))[..., 0], 2, 3)

    o = o.reshape(N, Lp, H, Dh)[:, :L].reshape(B, dilation, L, H, Dh).transpose(0, 2, 1, 3, 4).reshape(B, S, H, Dh)
    lse = lse.reshape(N, Lp, H)[:, :L].reshape(B, dilation, L, H).transpose(0, 2, 1, 3).reshape(B, S, H)
    return o, lse


def dilated_attention_mixer(q, k, v):
    B, S = q.shape[:2]
    slopes = jnp.asarray(alibi_slopes(N_ATTN_HEADS))
    outs, lses = [], []
    for gi, (window, dilation) in enumerate(ATTN_GROUPS):
        hs = slice(gi * HEADS_PER_GROUP, (gi + 1) * HEADS_PER_GROUP)
        o, lse = dilated_group_attention(q[:, :, hs], k[:, :, hs], v[:, :, hs], slopes[hs], window, dilation)
        outs.append(o)
        lses.append(lse)
    wts = jax.nn.softmax(jnp.stack(lses, axis=0), axis=0)
    y = jnp.sum(wts[..., None] * jnp.stack(outs, axis=0), axis=0)
    return y.reshape(B, S, ATTN_OUT_WIDTH).astype(q.dtype)


def causal_dwconv(u, w, b):
    S = u.shape[1]
    up = jnp.pad(u, ((0, 0), (CONV_WIDTH - 1, 0), (0, 0)))
    y = b
    for i in range(CONV_WIDTH):
        y = y + w[i] * up[:, i:i + S]
    return y


def setup_inputs(seed: int = 0) -> dict:
    key = jax.random.key(seed)
    ks = jax.random.split(key, 16)
    f32 = jnp.float32
    nrm = lambda k, shape, fan: jax.random.normal(k, shape, f32) * (fan ** -0.5)
    return {
        "x": jax.random.normal(ks[0], (BATCH, SEQ, D_MODEL), f32),
        "g_mix": 1.0 + 0.02 * jax.random.normal(ks[1], (DEPTH, D_MODEL), f32),
        "w_in": nrm(ks[2], (DEPTH, D_MODEL, IN_WIDTH), D_MODEL),
        "b_gate": 0.1 * jax.random.normal(ks[3], (DEPTH, N_BRANCHES * D_MODEL), f32),
        "w_pool_lin": nrm(ks[4], (DEPTH, POOL_GROUPS, POOL_GROUP_WIDTH, POOL_GROUP_WIDTH), POOL_GROUP_WIDTH),
        "pool_scale": 1.0 + 0.02 * jax.random.normal(ks[5], (DEPTH, POOL_WIDTH), f32),
        "w_pool_out": nrm(ks[6], (DEPTH, POOL_WIDTH, D_MODEL), POOL_WIDTH),
        "w_attn_out": nrm(ks[7], (DEPTH, ATTN_OUT_WIDTH, D_MODEL), ATTN_OUT_WIDTH),
        "w_out": nrm(ks[8], (DEPTH, D_MODEL, D_MODEL), D_MODEL),
        "g_ffn": 1.0 + 0.02 * jax.random.normal(ks[9], (DEPTH, D_MODEL), f32),
        "w_up": nrm(ks[10], (DEPTH, D_MODEL, 2 * D_FF), D_MODEL),
        "conv_w": nrm(ks[11], (DEPTH, CONV_WIDTH, 2 * D_FF), CONV_WIDTH),
        "conv_b": 0.02 * jax.random.normal(ks[12], (DEPTH, 2 * D_FF), f32),
        "w_down": nrm(ks[13], (DEPTH, D_FF, D_MODEL), D_FF),
        "g_final": 1.0 + 0.02 * jax.random.normal(ks[14], (D_MODEL,), f32),
    }


def reference(x, g_mix, w_in, b_gate, w_pool_lin, pool_scale, w_pool_out, w_attn_out, w_out,
              g_ffn, w_up, conv_w, conv_b, w_down, g_final):
    B, S, _ = x.shape
    o_q = POOL_WIDTH
    o_k = o_q + ATTN_WIDTH
    o_v = o_k + ATTN_WIDTH
    o_g = o_v + ATTN_WIDTH
    for l in range(DEPTH):
        h = rms_norm(x, g_mix[l])
        proj = h @ w_in[l]
        u = proj[..., :o_q]
        q = proj[..., o_q:o_k].reshape(B, S, N_ATTN_HEADS, HEAD_DIM)
        k = proj[..., o_k:o_v].reshape(B, S, N_ATTN_HEADS, HEAD_DIM)
        v = proj[..., o_v:o_g].reshape(B, S, N_ATTN_HEADS, HEAD_DIM)
        gates = jax.nn.sigmoid(proj[..., o_g:] + b_gate[l]).reshape(B, S, N_BRANCHES, D_MODEL)

        y_pool = pool_mixer(u, w_pool_lin[l], pool_scale[l]) @ w_pool_out[l]
        y_attn = dilated_attention_mixer(q, k, v) @ w_attn_out[l]
        mixed = gates[:, :, 0] * y_pool + gates[:, :, 1] * y_attn
        x = x + mixed @ w_out[l]

        h = rms_norm(x, g_ffn[l])
        up = causal_dwconv(h @ w_up[l], conv_w[l], conv_b[l])
        a, b = up[..., :D_FF], up[..., D_FF:]
        x = x + (jax.nn.gelu(a, approximate=False) * b) @ w_down[l]
    return rms_norm(x, g_final)
```

```cpp
#include <hip/hip_runtime.h>
#include <hip/hip_cooperative_groups.h>
#include <cstdio>
#include <cstdint>
namespace cg = cooperative_groups;

#define LAS __attribute__((address_space(3)))
typedef unsigned short bf16;
typedef short bf16x8 __attribute__((ext_vector_type(8)));
typedef short s16x4 __attribute__((ext_vector_type(4)));
typedef float f32x4 __attribute__((ext_vector_type(4)));
typedef float f32x2 __attribute__((ext_vector_type(2)));
typedef unsigned u32x4 __attribute__((ext_vector_type(4)));
typedef unsigned u32x2 __attribute__((ext_vector_type(2)));

constexpr int SEQ = 8192, DM = 2048, INW = 9728, PAW = 5632  , GWD = 4096  , FF = 5632, FF2 = 11264;
constexpr int OQ = 1024, OK_ = 2560, OV = 4096;
constexpr float RMS_EPS = 1e-6f;
constexpr int XB_ROWS = 8320;
constexpr int NT = 512, NWAVES = 8;

constexpr size_t MiB = 1u << 20;
constexpr size_t WS_SSQ1 = 0, WS_SSQ2 = 256 * 1024, WS_LSE = 512 * 1024;
constexpr size_t WS_WUP = 2 * MiB, WS_WDN = 46 * MiB, WS_WOUT = 68 * MiB, WS_WPO = 76 * MiB, WS_WAO = 80 * MiB, WS_WPL = 82 * MiB;
constexpr size_t WS_WIN = 83 * MiB, WS_H = 121 * MiB;
constexpr size_t WS_PA = 153 * MiB, WS_GATES = 241 * MiB;
constexpr size_t WS_POOLED = 305 * MiB, WS_PM = 321 * MiB, WS_AO = 337 * MiB;
constexpr size_t WS_OG = 83 * MiB;
constexpr size_t WS_T = 153 * MiB;
constexpr size_t WS_MIXED = 83 * MiB;
constexpr size_t WS_XB = 115 * MiB;
constexpr size_t WS_ACT = 153 * MiB;
constexpr size_t WS_END = 345 * MiB;

constexpr size_t WS_RSTD = 896 * 1024;
constexpr size_t WS_BAR = 1 * MiB;
constexpr int LDS_BYTES = 147456, RED_OFF = 131072, BARST_OFF = 147392;

#define LDS_WAIT() asm volatile("s_waitcnt lgkmcnt(0)" ::: "memory")

__device__ __forceinline__ unsigned cvt_pk_bf16(float lo, float hi) { unsigned r; asm volatile("v_cvt_pk_bf16_f32 %0, %1, %2" : "=v"(r) : "v"(lo), "v"(hi)); return r; }
__device__ __forceinline__ float bf_lo(unsigned w) { return __builtin_bit_cast(float, w << 16); }
__device__ __forceinline__ float bf_hi(unsigned w) { return __builtin_bit_cast(float, w & 0xffff0000u); }
__device__ __forceinline__ float wave_sum(float v) {
#pragma unroll
    for (int o = 1; o < 64; o <<= 1) v += __shfl_xor(v, o);
    return v;
}
__device__ __forceinline__ f32x2 gelu_pk(f32x2 v) {
    const f32x2 av = __builtin_elementwise_abs(v), d = av * 0.2316418882f + 1.0f;
    f32x2 t; t.x = __builtin_amdgcn_rcpf(d.x); t.y = __builtin_amdgcn_rcpf(d.y);
    f32x2 q = t * 0.5307027145f + (-0.7265760135f); q = q * t + 0.7107068705f; q = q * t + (-0.142248368f); q = q * t + 0.127414796f; q = q * t;
    const f32x2 s = (v * v) * (-0.72134752044f);
    f32x2 e; e.x = __builtin_amdgcn_exp2f(s.x); e.y = __builtin_amdgcn_exp2f(s.y);
    const f32x2 m = v * (q * e), r = v - m;
    f32x2 o; o.x = v.x < 0.f ? m.x : r.x; o.y = v.y < 0.f ? m.y : r.y; return o;
}
__device__ __forceinline__ f32x2 gelu_pk2(f32x2 v) {
    const f32x2 ax = __builtin_elementwise_abs(v) * 0.70710678f;
    f32x2 p = ax * 0.0000430638f + 0.0002765672f; p = p * ax + 0.0001520143f; p = p * ax + 0.0092705272f; p = p * ax + 0.0422820123f; p = p * ax + 0.0705230784f; p = p * ax + 1.0f;
    p = p * p; p = p * p; p = p * p; p = p * p;
    f32x2 r; r.x = __builtin_amdgcn_rcpf(p.x); r.y = __builtin_amdgcn_rcpf(p.y);
    const f32x2 m = (v * 0.5f) * r, q = v - m;
    f32x2 o; o.x = v.x < 0.f ? m.x : q.x; o.y = v.y < 0.f ? m.y : q.y; return o;
}
__device__ __forceinline__ f32x2 gelu_pk3(f32x2 v) {
    const f32x2 av = __builtin_elementwise_abs(v), ax = av * 0.70710678f;
    f32x2 p = ax * 0.0000430638f + 0.0002765672f; p = p * ax + 0.0001520143f; p = p * ax + 0.0092705272f; p = p * ax + 0.0422820123f; p = p * ax + 0.0705230784f; p = p * ax + 1.0f;
    p = p * p; p = p * p; p = p * p; p = p * p;
    f32x2 r; r.x = __builtin_amdgcn_rcpf(p.x); r.y = __builtin_amdgcn_rcpf(p.y);
    return ((v + av) - av * r) * 0.5f;
}
__device__ __forceinline__ float sigmoidf_(float z) { return __builtin_amdgcn_rcpf(1.f + __expf(-z)); }

namespace pg8 {
typedef unsigned short bf16_t;
constexpr int BM = 256, BK = 64, HALF = 128, HTB = HALF * BK * 2, NXCD = 8, WGM = 4;

__host__ __device__ __forceinline__ int lds_byte(int r, int c) { const int st = (r >> 4) * 2 + (c >> 5), rr = r & 15, cc = c & 31, ob = rr * 64 + cc * 2; return st * 1024 + (ob ^ (((ob >> 9) & 1) << 5)); }
__host__ __device__ __forceinline__ void stage_rc(int b, int& R, int& C) { const int st = b / 1024, sb = b % 1024, swz = sb ^ (((sb >> 9) & 1) << 5); R = (st >> 1) * 16 + swz / 64; C = (st & 1) * 32 + (swz % 64) / 2; }
__host__ __device__ __forceinline__ int perm32(int rho) { const int n = rho >> 4, i = rho & 15; return 8 * (i >> 2) + 4 * n + (i & 3); }

struct Unit { int pm, pn; };
struct Gemm { const bf16_t* A; const bf16_t* Bt; int lda, ldb, K, a_pn_off; };

struct StaticOrder {
    int nM, nN, nwg, G, c;
    __host__ __device__ void init(int nM_, int nN_, int G_, int c_) { nM = nM_; nN = nN_; nwg = nM * nN; G = G_; c = c_; }
    __host__ __device__ bool next(int i, Unit& u) const {
        const long L = (long)i * G + c; if (L >= nwg) return false;
        int wgid = (int)L; { const int q = nwg / NXCD, r = nwg % NXCD, xcd = wgid % NXCD, off = wgid / NXCD; wgid = (xcd < r ? xcd * (q + 1) : r * (q + 1) + (xcd - r) * q) + off; }
        const int nig = WGM * nN, gid = wgid / nig, fm = gid * WGM, gsz = (nM - fm) < WGM ? (nM - fm) : WGM;
        u.pm = fm + ((wgid % nig) % gsz); u.pn = (wgid % nig) / gsz; return true;
    }
};

template <class Epi, bool CONV>
__device__ __forceinline__ void gemm_phase(LAS unsigned char* lds, const Gemm g, const StaticOrder& S, const Epi& E) {
    const int tid = threadIdx.x, wid = __builtin_amdgcn_readfirstlane(tid >> 6), lane = tid & 63, wr = wid >> 2, wc = wid & 3, fr = lane & 15, fq = lane >> 4;
    const int K = g.K, nt = K / BK;
    unsigned voffA[2], voffB[2];
#pragma unroll
    for (int i = 0; i < 2; ++i) { int R, C; stage_rc(tid * 16 + i * 8192, R, C); const int Rb = (R & ~31) + perm32(R & 31);
        const int Ra = CONV ? (126 * (R >> 6) + 8 * (R & 15) + ((R >> 4) & 3)) : R;
        voffA[i] = (unsigned)(Ra * g.lda + C) * 2u; voffB[i] = (unsigned)(Rb * g.ldb + C) * 2u; }
    const size_t kstep = (size_t)(BK * 2);
    const size_t hstepA = (size_t)(CONV ? 4 : HALF) * g.lda * 2, hstepB = (size_t)HALF * g.ldb * 2;
    const size_t tstepA = (size_t)(CONV ? 252 : 256) * g.lda * 2, tstepB = (size_t)256 * g.ldb * 2;
    const unsigned ldsw = (unsigned)wid * 1024u;
    const int aoff = lds_byte(wr * 64 + fr, fq * 8), boff = lds_byte(wc * 32 + fr, fq * 8);
#define PG8_SA(b, h) (((b) * 2 + (h)) * HTB)
#define PG8_SB(b, h) ((4 + (b) * 2 + (h)) * HTB)
#define PG8_STAGE(bufoff, gbase, voff) do { _Pragma("unroll") for (int _i = 0; _i < 2; ++_i) \
        __builtin_amdgcn_global_load_lds((const unsigned*)((const char*)(gbase) + (voff)[_i]), (LAS unsigned*)(lds + (bufoff) + ldsw + _i * 8192), 16, 0, 0); } while (0)
#define PG8_LDA(dst, b, h) do { _Pragma("unroll") for (int m = 0; m < 4; ++m) _Pragma("unroll") for (int k = 0; k < 2; ++k) dst[m][k] = *(const LAS bf16x8*)(lds + PG8_SA(b, h) + aoff + m * 2048 + k * 1024); } while (0)
#define PG8_LDB(dst, b, h) do { _Pragma("unroll") for (int n = 0; n < 2; ++n) _Pragma("unroll") for (int k = 0; k < 2; ++k) dst[n][k] = *(const LAS bf16x8*)(lds + PG8_SB(b, h) + boff + n * 2048 + k * 1024); } while (0)
#define PG8_MMA(ai, bj, At, Bt) do { __builtin_amdgcn_s_setprio(1); _Pragma("unroll") for (int m = 0; m < 4; ++m) _Pragma("unroll") for (int n = 0; n < 2; ++n) _Pragma("unroll") for (int k = 0; k < 2; ++k) \
        acc[ai][bj][m][n] = __builtin_amdgcn_mfma_f32_16x16x32_bf16(Bt[n][k], At[m][k], acc[ai][bj][m][n], 0, 0, 0); __builtin_amdgcn_s_setprio(0); } while (0)
#define PG8_WAIT_V(n) asm volatile("s_waitcnt vmcnt(" #n ")" ::: "memory")
#define PG8_WAIT_L(n) asm volatile("s_waitcnt lgkmcnt(" #n ")" ::: "memory")
#define PG8_BAR __builtin_amdgcn_s_barrier()
#define PG8_SCHED __builtin_amdgcn_sched_barrier(0)
    Unit cur, nxt; int ui = 0;
    if (!S.next(0, cur)) return;
    f32x4 acc[2][2][4][2];
#pragma unroll
    for (int a = 0; a < 2; ++a)
#pragma unroll
        for (int b = 0; b < 2; ++b)
#pragma unroll
            for (int m = 0; m < 4; ++m)
#pragma unroll
                for (int n = 0; n < 2; ++n) acc[a][b][m][n] = (f32x4){0.f, 0.f, 0.f, 0.f};
    bf16x8 At[4][2], B0[2][2], B1[2][2];
    f32x4 epre = {0.f, 0.f, 0.f, 0.f};
    const char* cA = (const char*)g.A + (size_t)cur.pm * tstepA + (size_t)cur.pn * g.a_pn_off; const char* cB = (const char*)g.Bt + (size_t)cur.pn * tstepB;
    PG8_STAGE(PG8_SB(0, 0), cB, voffB); PG8_STAGE(PG8_SB(0, 1), cB + hstepB, voffB); PG8_STAGE(PG8_SA(0, 0), cA, voffA); PG8_STAGE(PG8_SA(0, 1), cA + hstepA, voffA);
    if (wr == 1) PG8_BAR;
    PG8_WAIT_V(2); PG8_BAR;
    PG8_STAGE(PG8_SB(1, 0), cB + kstep, voffB); PG8_STAGE(PG8_SA(1, 0), cA + kstep, voffA); PG8_STAGE(PG8_SB(1, 1), cB + hstepB + kstep, voffB);
    PG8_WAIT_V(6); PG8_BAR;
    for (;;) {
        const bool has_next = S.next(ui + 1, nxt);
        const char* nA = has_next ? (const char*)g.A + (size_t)nxt.pm * tstepA + (size_t)nxt.pn * g.a_pn_off : cA; const char* nB = has_next ? (const char*)g.Bt + (size_t)nxt.pn * tstepB : cB;
#define PG8_KBODY(t) do { \
            const bool last = (t == nt - 2); \
            if constexpr (Epi::PRE) { if (last) epre = E.pre(cur); } \
            const char* a1 = cA + (size_t)(t + 1) * kstep; \
            const char* a2 = last ? nA : cA + (size_t)(t + 2) * kstep; const char* b2 = last ? nB : cB + (size_t)(t + 2) * kstep; \
            const char* a3 = a2 + kstep; const char* b3 = b2 + kstep; \
            PG8_LDB(B0, 0, 0); PG8_LDB(B1, 0, 1); PG8_SCHED; PG8_LDA(At, 0, 0); PG8_STAGE(PG8_SA(1, 1), a1 + hstepA, voffA); \
            PG8_WAIT_V(8); PG8_WAIT_L(0); PG8_BAR; PG8_MMA(0, 0, At, B0); PG8_MMA(0, 1, At, B1); PG8_BAR; PG8_SCHED; \
            PG8_LDA(At, 0, 1); PG8_STAGE(PG8_SB(0, 0), b2, voffB); PG8_STAGE(PG8_SB(0, 1), b2 + hstepB, voffB); PG8_STAGE(PG8_SA(0, 0), a2, voffA); \
            PG8_WAIT_V(8); PG8_WAIT_L(0); PG8_BAR; PG8_MMA(1, 0, At, B0); PG8_MMA(1, 1, At, B1); PG8_BAR; PG8_SCHED; \
            PG8_LDB(B0, 1, 0); PG8_LDB(B1, 1, 1); PG8_SCHED; PG8_LDA(At, 1, 0); PG8_STAGE(PG8_SA(0, 1), a2 + hstepA, voffA); \
            PG8_WAIT_V(8); PG8_WAIT_L(0); PG8_BAR; PG8_MMA(0, 0, At, B0); PG8_MMA(0, 1, At, B1); PG8_BAR; PG8_SCHED; \
            PG8_LDA(At, 1, 1); PG8_STAGE(PG8_SB(1, 0), b3, voffB); PG8_STAGE(PG8_SB(1, 1), b3 + hstepB, voffB); PG8_STAGE(PG8_SA(1, 0), a3, voffA); \
            PG8_WAIT_V(8); PG8_WAIT_L(0); PG8_BAR; PG8_MMA(1, 0, At, B0); PG8_MMA(1, 1, At, B1); PG8_BAR; PG8_SCHED; \
        } while (0)
        if constexpr (Epi::TSPLIT >= 0) {
#pragma unroll 1
            for (int t = 0; t < Epi::TSPLIT; t += 2) PG8_KBODY(t);
            E.mid(acc, cur, wr, wc, fr, fq);
#pragma unroll 1
            for (int t = Epi::TSPLIT; t < nt; t += 2) PG8_KBODY(t);
        } else {
#pragma unroll 1
            for (int t = 0; t < nt; t += 2) PG8_KBODY(t);
        }
#undef PG8_KBODY
        if (wr == 0) PG8_BAR;
        if constexpr (Epi::PRE) E(acc, cur, wr, wc, fr, fq, epre); else E(acc, cur, wr, wc, fr, fq);
        if (!has_next) break;
#pragma unroll
        for (int a = 0; a < 2; ++a)
#pragma unroll
            for (int b = 0; b < 2; ++b)
#pragma unroll
                for (int m = 0; m < 4; ++m)
#pragma unroll
                    for (int n = 0; n < 2; ++n) acc[a][b][m][n] = (f32x4){0.f, 0.f, 0.f, 0.f};
        cur = nxt; cA = nA; cB = nB; ++ui;
        if (wr == 1) PG8_BAR;
    }
    PG8_WAIT_V(0);
    PG8_BAR;
#undef PG8_SA
#undef PG8_SB
#undef PG8_STAGE
#undef PG8_LDA
#undef PG8_LDB
#undef PG8_MMA
#undef PG8_WAIT_V
#undef PG8_WAIT_L
#undef PG8_BAR
#undef PG8_SCHED
}

typedef f32x4 Acc[2][2][4][2];

struct EpiProj {
    static constexpr int TSPLIT = -1; static constexpr bool PRE = false;
    bf16_t* PA; bf16_t* GT; const float* bg;
    __device__ __forceinline__ void operator()(const Acc& acc, const Unit& u, int wr, int wc, int fr, int fq) const {
        const bool gate = u.pn >= 22;
        const int row0 = u.pm * BM + wr * 64 + fr, ldc = gate ? GWD : PAW, colt = (gate ? (u.pn - 22) : u.pn) * BM + wc * 32 + 8 * fq;
        bf16_t* base = gate ? GT : PA;
        f32x4 bv[2][2];
#pragma unroll
        for (int bj = 0; bj < 2; ++bj)
#pragma unroll
            for (int n = 0; n < 2; ++n) bv[bj][n] = gate ? *(const f32x4*)(bg + colt + bj * HALF + 4 * n) : (f32x4){0.f, 0.f, 0.f, 0.f};
#pragma unroll
        for (int ai = 0; ai < 2; ++ai)
#pragma unroll
            for (int m = 0; m < 4; ++m) { bf16_t* rowp = base + (size_t)(row0 + ai * HALF + m * 16) * ldc + colt;
#pragma unroll
                for (int bj = 0; bj < 2; ++bj) { f32x4 v0 = acc[ai][bj][m][0] + bv[bj][0], v1 = acc[ai][bj][m][1] + bv[bj][1];
                    if (gate) {
#pragma unroll
                        for (int e = 0; e < 4; ++e) { v0[e] = sigmoidf_(v0[e]); v1[e] = sigmoidf_(v1[e]); } }
                    u32x4 w; w.x = cvt_pk_bf16(v0[0], v0[1]); w.y = cvt_pk_bf16(v0[2], v0[3]); w.z = cvt_pk_bf16(v1[0], v1[1]); w.w = cvt_pk_bf16(v1[2], v1[3]);
                    *(u32x4*)(rowp + bj * HALF) = w; } }
    }
};

struct EpiScale {
    static constexpr int TSPLIT = -1; static constexpr bool PRE = false;
    bf16_t* O; int ldc; const float* sc;
    __device__ __forceinline__ void operator()(const Acc& acc, const Unit& u, int wr, int wc, int fr, int fq) const {
        const int row0 = u.pm * BM + wr * 64 + fr, col0 = u.pn * BM + wc * 32 + 8 * fq;
        f32x4 sv[2][2];
#pragma unroll
        for (int bj = 0; bj < 2; ++bj)
#pragma unroll
            for (int n = 0; n < 2; ++n) sv[bj][n] = *(const f32x4*)(sc + col0 + bj * HALF + 4 * n);
#pragma unroll
        for (int ai = 0; ai < 2; ++ai)
#pragma unroll
            for (int m = 0; m < 4; ++m) { bf16_t* rowp = O + (size_t)(row0 + ai * HALF + m * 16) * ldc + col0;
#pragma unroll
                for (int bj = 0; bj < 2; ++bj) { const f32x4 v0 = acc[ai][bj][m][0] * sv[bj][0], v1 = acc[ai][bj][m][1] * sv[bj][1];
                    u32x4 w; w.x = cvt_pk_bf16(v0[0], v0[1]); w.y = cvt_pk_bf16(v0[2], v0[3]); w.z = cvt_pk_bf16(v1[0], v1[1]); w.w = cvt_pk_bf16(v1[2], v1[3]);
                    *(u32x4*)(rowp + bj * HALF) = w; } }
    }
};

template <bool SECOND> struct EpiGate {
    static constexpr int TSPLIT = -1; static constexpr bool PRE = false;
    const bf16_t* GT; float* T; bf16_t* MX;
    __device__ __forceinline__ void operator()(const Acc& acc, const Unit& u, int wr, int wc, int fr, int fq) const {
        const int row0 = u.pm * BM + wr * 64 + fr, col0 = u.pn * BM + wc * 32 + 8 * fq;
#pragma unroll
        for (int ai = 0; ai < 2; ++ai)
#pragma unroll
            for (int m = 0; m < 4; ++m) { const size_t row = (size_t)(row0 + ai * HALF + m * 16);
#pragma unroll
                for (int bj = 0; bj < 2; ++bj) { const int col = col0 + bj * HALF;
                    const u32x4 gw = *(const u32x4*)(GT + row * GWD + (SECOND ? DM : 0) + col);
                    f32x4 g0 = {bf_lo(gw.x), bf_hi(gw.x), bf_lo(gw.y), bf_hi(gw.y)}, g1 = {bf_lo(gw.z), bf_hi(gw.z), bf_lo(gw.w), bf_hi(gw.w)};
                    f32x4 v0 = acc[ai][bj][m][0] * g0, v1 = acc[ai][bj][m][1] * g1;
                    float* tp = T + row * DM + col;
                    if (!SECOND) { *(f32x4*)tp = v0; *(f32x4*)(tp + 4) = v1; }
                    else { v0 += *(const f32x4*)tp; v1 += *(const f32x4*)(tp + 4);
                        u32x4 w; w.x = cvt_pk_bf16(v0[0], v0[1]); w.y = cvt_pk_bf16(v0[2], v0[3]); w.z = cvt_pk_bf16(v1[0], v1[1]); w.w = cvt_pk_bf16(v1[2], v1[3]);
                        *(u32x4*)(MX + row * DM + col) = w; } } }
    }
};

struct EpiGateCat {
    static constexpr int TSPLIT = 16; static constexpr bool PRE = false;
    const bf16_t* GT; bf16_t* MX;
    __device__ __forceinline__ void mid(Acc& acc, const Unit& u, int wr, int wc, int fr, int fq) const {
        int row0 = u.pm * BM + wr * 64 + fr, col0 = u.pn * BM + wc * 32 + 8 * fq;
        asm volatile("" : "+v"(row0), "+v"(col0));
#pragma unroll
        for (int ai = 0; ai < 2; ++ai) {
            u32x4 ga[4][2], gb[4][2];
#pragma unroll
            for (int m = 0; m < 4; ++m)
#pragma unroll
                for (int bj = 0; bj < 2; ++bj) { const bf16_t* gp = GT + (size_t)(row0 + ai * HALF + m * 16) * GWD + col0 + bj * HALF; ga[m][bj] = *(const u32x4*)gp; gb[m][bj] = *(const u32x4*)(gp + DM); }
#pragma unroll
            for (int m = 0; m < 4; ++m)
#pragma unroll
                for (int bj = 0; bj < 2; ++bj) { const u32x4 a = ga[m][bj], b = gb[m][bj];
                    const f32x4 n0 = {bf_lo(a.x), bf_hi(a.x), bf_lo(a.y), bf_hi(a.y)}, n1 = {bf_lo(a.z), bf_hi(a.z), bf_lo(a.w), bf_hi(a.w)};
                    const f32x4 d0 = {bf_lo(b.x), bf_hi(b.x), bf_lo(b.y), bf_hi(b.y)}, d1 = {bf_lo(b.z), bf_hi(b.z), bf_lo(b.w), bf_hi(b.w)};
                    f32x4 r0, r1;
#pragma unroll
                    for (int e = 0; e < 4; ++e) { r0[e] = n0[e] * __builtin_amdgcn_rcpf(d0[e]); r1[e] = n1[e] * __builtin_amdgcn_rcpf(d1[e]); }
                    acc[ai][bj][m][0] = acc[ai][bj][m][0] * r0; acc[ai][bj][m][1] = acc[ai][bj][m][1] * r1; }
        }
    }
    __device__ __forceinline__ void operator()(const Acc& acc, const Unit& u, int wr, int wc, int fr, int fq) const {
        int row0 = u.pm * BM + wr * 64 + fr, col0 = u.pn * BM + wc * 32 + 8 * fq;
        asm volatile("" : "+v"(row0), "+v"(col0));
        u32x4 gl[2][4][2];
#pragma unroll
        for (int ai = 0; ai < 2; ++ai)
#pragma unroll
            for (int m = 0; m < 4; ++m)
#pragma unroll
                for (int bj = 0; bj < 2; ++bj) gl[ai][m][bj] = *(const u32x4*)(GT + (size_t)(row0 + ai * HALF + m * 16) * GWD + DM + col0 + bj * HALF);
#pragma unroll
        for (int ai = 0; ai < 2; ++ai)
#pragma unroll
            for (int m = 0; m < 4; ++m) { const size_t row = (size_t)(row0 + ai * HALF + m * 16);
#pragma unroll
                for (int bj = 0; bj < 2; ++bj) { const int col = col0 + bj * HALF;
                    const u32x4 b = gl[ai][m][bj];
                    const f32x4 d0 = {bf_lo(b.x), bf_hi(b.x), bf_lo(b.y), bf_hi(b.y)}, d1 = {bf_lo(b.z), bf_hi(b.z), bf_lo(b.w), bf_hi(b.w)};
                    const f32x4 v0 = acc[ai][bj][m][0] * d0, v1 = acc[ai][bj][m][1] * d1;
                    u32x4 w; w.x = cvt_pk_bf16(v0[0], v0[1]); w.y = cvt_pk_bf16(v0[2], v0[3]); w.z = cvt_pk_bf16(v1[0], v1[1]); w.w = cvt_pk_bf16(v1[2], v1[3]);
                    *(u32x4*)(MX + row * DM + col) = w; } }
    }
};

template <bool WRITE_XB> struct EpiResSsq {
    static constexpr int TSPLIT = -1; static constexpr bool PRE = false;
    const float* base; float* out; bf16_t* XB; const float* g; float* ssq; LAS float* red; unsigned* cnt; float* rstd; int wout;
    __device__ __forceinline__ void operator()(const Acc& acc, const Unit& u, int wr, int wc, int fr, int fq) const {
        const int row0 = u.pm * BM + wr * 64 + fr, col0 = u.pn * BM + wc * 32 + 8 * fq;
#pragma unroll
        for (int ai = 0; ai < 2; ++ai) {
            f32x4 bl[4][2][2];
#pragma unroll
            for (int m = 0; m < 4; ++m)
#pragma unroll
                for (int bj = 0; bj < 2; ++bj) { const float* bp = base + (size_t)(row0 + ai * HALF + m * 16) * DM + col0 + bj * HALF; bl[m][bj][0] = *(const f32x4*)bp; bl[m][bj][1] = *(const f32x4*)(bp + 4); }
#pragma unroll
            for (int m = 0; m < 4; ++m) { const size_t row = (size_t)(row0 + ai * HALF + m * 16); float ss = 0.f;
#pragma unroll
                for (int bj = 0; bj < 2; ++bj) { const int col = col0 + bj * HALF;
                    float* op = out + row * DM + col;
                    const f32x4 v0 = bl[m][bj][0] + acc[ai][bj][m][0], v1 = bl[m][bj][1] + acc[ai][bj][m][1];
                    if (!WRITE_XB || wout) { *(f32x4*)op = v0; *(f32x4*)(op + 4) = v1; }
                    ss += (v0[0] * v0[0] + v0[1] * v0[1]) + (v0[2] * v0[2] + v0[3] * v0[3]) + (v1[0] * v1[0] + v1[1] * v1[1]) + (v1[2] * v1[2] + v1[3] * v1[3]);
                    if (WRITE_XB) { const f32x4 a0 = v0, a1 = v1;
                        u32x4 w; w.x = cvt_pk_bf16(a0[0], a0[1]); w.y = cvt_pk_bf16(a0[2], a0[3]); w.z = cvt_pk_bf16(a1[0], a1[1]); w.w = cvt_pk_bf16(a1[2], a1[3]);
                        *(u32x4*)(XB + (row + 2) * DM + col) = w; } }
                ss += __shfl_xor(ss, 16); ss += __shfl_xor(ss, 32);
                if (fq == 0) red[wc * 256 + ai * HALF + wr * 64 + m * 16 + fr] = ss; } }
        __syncthreads();
        const int tid = threadIdx.x;
        if (!WRITE_XB) {
            if (tid < 256) ssq[(size_t)u.pn * SEQ + u.pm * BM + tid] = (red[tid] + red[256 + tid]) + (red[512 + tid] + red[768 + tid]);
            __syncthreads();
        } else {
            if (tid < 256) { const float pv = (red[tid] + red[256 + tid]) + (red[512 + tid] + red[768 + tid]);
                __hip_atomic_store((unsigned*)ssq + (size_t)u.pn * SEQ + u.pm * BM + tid, __builtin_bit_cast(unsigned, pv), __ATOMIC_RELAXED, __HIP_MEMORY_SCOPE_AGENT); }
            asm volatile("s_waitcnt vmcnt(0)" ::: "memory");
            __syncthreads();
            if (tid == 0) { const unsigned old = __hip_atomic_fetch_add(cnt + 64 * u.pm, 1u, __ATOMIC_RELAXED, __HIP_MEMORY_SCOPE_AGENT); ((LAS unsigned*)red)[1024] = (old == 7u) ? 1u : 0u; }
            __syncthreads();
            if (((LAS unsigned*)red)[1024] != 0u && tid < 256) { float sm = 0.f;
#pragma unroll
                for (int p = 0; p < 8; ++p) sm += __builtin_bit_cast(float, __hip_atomic_load((unsigned*)ssq + (size_t)p * SEQ + u.pm * BM + tid, __ATOMIC_RELAXED, __HIP_MEMORY_SCOPE_AGENT));
                rstd[2 + u.pm * BM + tid] = __builtin_amdgcn_rsqf(sm * (1.f / DM) + RMS_EPS); }
            __syncthreads();
        }
    }
};

struct EpiResNorm {
    static constexpr int TSPLIT = -1; static constexpr bool PRE = false;
    float* out; const float* gf; float* ssq; unsigned* cnt; LAS float* red; const bf16_t* XB;
    __device__ __forceinline__ void operator()(Acc& acc, const Unit& u, int wr, int wc, int fr, int fq) const {
        const int row0 = u.pm * BM + wr * 64 + fr, col0 = u.pn * BM + wc * 32 + 8 * fq;
        u32x4 xb[2][4][2];
#pragma unroll
        for (int ai = 0; ai < 2; ++ai)
#pragma unroll
            for (int m = 0; m < 4; ++m)
#pragma unroll
                for (int bj = 0; bj < 2; ++bj) xb[ai][m][bj] = *(const u32x4*)(XB + (size_t)(row0 + ai * HALF + m * 16 + 2) * DM + col0 + bj * HALF);
#pragma unroll
        for (int ai = 0; ai < 2; ++ai)
#pragma unroll
            for (int m = 0; m < 4; ++m) { float ss = 0.f;
#pragma unroll
                for (int bj = 0; bj < 2; ++bj) { const u32x4 w = xb[ai][m][bj];
                    const f32x4 v0 = (f32x4){bf_lo(w.x), bf_hi(w.x), bf_lo(w.y), bf_hi(w.y)} + acc[ai][bj][m][0], v1 = (f32x4){bf_lo(w.z), bf_hi(w.z), bf_lo(w.w), bf_hi(w.w)} + acc[ai][bj][m][1];
                    acc[ai][bj][m][0] = v0; acc[ai][bj][m][1] = v1;
                    ss += (v0[0] * v0[0] + v0[1] * v0[1]) + (v0[2] * v0[2] + v0[3] * v0[3]) + (v1[0] * v1[0] + v1[1] * v1[1]) + (v1[2] * v1[2] + v1[3] * v1[3]); }
                ss += __shfl_xor(ss, 16); ss += __shfl_xor(ss, 32);
                if (fq == 0) red[wc * 256 + ai * HALF + wr * 64 + m * 16 + fr] = ss; }
        __syncthreads();
        const int tid = threadIdx.x;
        if (tid < 256) { const float pv = (red[tid] + red[256 + tid]) + (red[512 + tid] + red[768 + tid]);
            __hip_atomic_store((unsigned*)ssq + (size_t)u.pn * SEQ + u.pm * BM + tid, __builtin_bit_cast(unsigned, pv), __ATOMIC_RELAXED, __HIP_MEMORY_SCOPE_AGENT); }
        asm volatile("s_waitcnt vmcnt(0)" ::: "memory");
        __syncthreads();
        if (tid == 0) { unsigned* c = cnt + 64 * u.pm;
            __hip_atomic_fetch_add(c, 1u, __ATOMIC_RELAXED, __HIP_MEMORY_SCOPE_AGENT);
            unsigned sp = 0; while (__hip_atomic_load(c, __ATOMIC_RELAXED, __HIP_MEMORY_SCOPE_AGENT) < 8u) { __builtin_amdgcn_s_sleep(1); if (++sp > (1u << 22)) break; } }
        __syncthreads();
        if (tid < 256) { float s = 0.f;
#pragma unroll
            for (int p = 0; p < 8; ++p) s += __builtin_bit_cast(float, __hip_atomic_load((unsigned*)ssq + (size_t)p * SEQ + u.pm * BM + tid, __ATOMIC_RELAXED, __HIP_MEMORY_SCOPE_AGENT));
            red[tid] = __builtin_amdgcn_rsqf(s * (1.f / DM) + RMS_EPS); }
        f32x4 gv[2][2];
#pragma unroll
        for (int bj = 0; bj < 2; ++bj)
#pragma unroll
            for (int n = 0; n < 2; ++n) gv[bj][n] = *(const f32x4*)(gf + col0 + bj * HALF + 4 * n);
        __syncthreads();
#pragma unroll
        for (int ai = 0; ai < 2; ++ai)
#pragma unroll
            for (int m = 0; m < 4; ++m) { const size_t row = (size_t)(row0 + ai * HALF + m * 16);
                const float rstd = red[ai * HALF + wr * 64 + m * 16 + fr];
#pragma unroll
                for (int bj = 0; bj < 2; ++bj) { float* op = out + row * DM + col0 + bj * HALF;
                    *(f32x4*)op = acc[ai][bj][m][0] * rstd * gv[bj][0]; *(f32x4*)(op + 4) = acc[ai][bj][m][1] * rstd * gv[bj][1]; } }
        __syncthreads();
    }
};

struct EpiConvGelu {
    static constexpr int TSPLIT = -1; static constexpr bool PRE = true;
    bf16_t* ACT; const float* rstd2; const float* cw; const float* cb; LAS float* prm;
    __device__ __forceinline__ f32x4 pre(const Unit& u) const {
        const int tid = threadIdx.x; f32x4 v = {0.f, 0.f, 0.f, 0.f};
        if (tid < 256) { const int k = tid >> 5, c4 = (tid & 31) * 4, kk = k & 3, chn = ((k >> 2) ? FF : 0) + u.pn * HALF + c4;
            v = *(const f32x4*)((kk < 3 ? cw + (size_t)kk * FF2 : cb) + chn); }
        else if (tid < 320) v = *(const f32x4*)(rstd2 + u.pm * 252 + (tid - 256) * 4);
        return v;
    }
    __device__ __forceinline__ void operator()(const Acc& acc, const Unit& u, int wr, int wc, int fr, int fq, f32x4 epre) const {
        const int tok0 = u.pm * 252 + wr * 126 - 2 + fr * 8;
        { const int tid = threadIdx.x;
          if (tid < 256) *(LAS f32x4*)(prm + (tid >> 5) * 128 + (tid & 31) * 4) = epre;
          else if (tid < 320) *(LAS f32x4*)(prm + 1024 + (tid - 256) * 4) = epre; }
        __syncthreads();
        float r[8];
#pragma unroll
        for (int j = 0; j < 8; ++j) r[j] = prm[1024 + wr * 126 + fr * 8 + j];
        const int cl = wc * 32 + fq * 8;
        const int ch0 = u.pn * HALF + wc * 32 + fq * 8;
        unsigned pk[8][4];
#pragma unroll
        for (int n = 0; n < 2; ++n) {
            const LAS float* pp = prm + cl + 4 * n;
            const f32x4 w0a = *(const LAS f32x4*)(pp), w1a = *(const LAS f32x4*)(pp + 128), w2a = *(const LAS f32x4*)(pp + 256), ba = *(const LAS f32x4*)(pp + 384);
            const f32x4 w0b = *(const LAS f32x4*)(pp + 512), w1b = *(const LAS f32x4*)(pp + 640), w2b = *(const LAS f32x4*)(pp + 768), bb = *(const LAS f32x4*)(pp + 896);
#pragma unroll
            for (int e2 = 0; e2 < 2; ++e2) {
                const f32x2 W0a = {w0a[2 * e2], w0a[2 * e2 + 1]}, W1a = {w1a[2 * e2], w1a[2 * e2 + 1]}, W2a = {w2a[2 * e2], w2a[2 * e2 + 1]}, Ba = {ba[2 * e2], ba[2 * e2 + 1]};
                const f32x2 W0b = {w0b[2 * e2], w0b[2 * e2 + 1]}, W1b = {w1b[2 * e2], w1b[2 * e2 + 1]}, W2b = {w2b[2 * e2], w2b[2 * e2 + 1]}, Bb = {bb[2 * e2], bb[2 * e2 + 1]};
                f32x2 ya[8], yb[8];
#pragma unroll
                for (int j = 0; j < 8; ++j) { const f32x4 va = acc[j >> 2][0][j & 3][n], vb = acc[j >> 2][1][j & 3][n];
                    ya[j] = (f32x2){va[2 * e2], va[2 * e2 + 1]} * r[j]; yb[j] = (f32x2){vb[2 * e2], vb[2 * e2 + 1]} * r[j]; }
                f32x2 am1, am2, bm1, bm2;
                am1.x = __shfl_up(ya[7].x, 1, 16); am1.y = __shfl_up(ya[7].y, 1, 16); am2.x = __shfl_up(ya[6].x, 1, 16); am2.y = __shfl_up(ya[6].y, 1, 16);
                bm1.x = __shfl_up(yb[7].x, 1, 16); bm1.y = __shfl_up(yb[7].y, 1, 16); bm2.x = __shfl_up(yb[6].x, 1, 16); bm2.y = __shfl_up(yb[6].y, 1, 16);
#pragma unroll
                for (int j = 0; j < 8; ++j) {
                    const f32x2 a2 = (j >= 2) ? ya[j >= 2 ? j - 2 : 0] : (j == 1 ? am1 : am2), a1 = (j >= 1) ? ya[j >= 1 ? j - 1 : 0] : am1;
                    const f32x2 b2 = (j >= 2) ? yb[j >= 2 ? j - 2 : 0] : (j == 1 ? bm1 : bm2), b1 = (j >= 1) ? yb[j >= 1 ? j - 1 : 0] : bm1;
                    const f32x2 cva = Ba + W0a * a2 + W1a * a1 + W2a * ya[j];
                    const f32x2 cvb = Bb + W0b * b2 + W1b * b1 + W2b * yb[j];
                    const f32x2 gl = gelu_pk3(cva) * cvb;
                    pk[j][2 * n + e2] = cvt_pk_bf16(gl.x, gl.y); }
            }
        }
#pragma unroll
        for (int j = 0; j < 8; ++j) { const int t = tok0 + j;
            if (t >= 0 && t < SEQ && !(fr == 0 && j < 2)) { u32x4 w; w.x = pk[j][0]; w.y = pk[j][1]; w.z = pk[j][2]; w.w = pk[j][3];
                *(u32x4*)(ACT + (size_t)t * FF + ch0) = w; } }
    }
};
}

__device__ __forceinline__ void transpose_load(const float* __restrict__ W, int N, int k0, int n0, int lane, f32x4 (&v)[8]) {
    const int r = lane >> 3, c4 = (lane & 7) * 4;
#pragma unroll
    for (int i = 0; i < 8; ++i) v[i] = __builtin_nontemporal_load((const f32x4*)(W + (size_t)(k0 + 8 * i + r) * N + n0 + c4));
}
__device__ __forceinline__ void transpose_emit(f32x4 (&v)[8], bf16* WT, int ldt, int d0, LAS float* scr, int k0, int lane, const float* __restrict__ rs) {
    const int r = lane >> 3, c4 = (lane & 7) * 4, c = lane & 7;
    if (rs) {
#pragma unroll
        for (int i = 0; i < 8; ++i) v[i] = v[i] * rs[k0 + 8 * i + r]; }
#pragma unroll
    for (int i = 0; i < 8; ++i) { LAS float* d = scr + (8 * i + r) * 33 + c4; d[0] = v[i][0]; d[1] = v[i][1]; d[2] = v[i][2]; d[3] = v[i][3]; }
    LDS_WAIT(); asm volatile("" ::: "memory");
#pragma unroll
    for (int j = 0; j < 4; ++j) { const int n = (lane >> 3) + 8 * j; const LAS float* sp = scr + (8 * c) * 33 + n;
        u32x4 o; o.x = cvt_pk_bf16(sp[0 * 33], sp[1 * 33]); o.y = cvt_pk_bf16(sp[2 * 33], sp[3 * 33]); o.z = cvt_pk_bf16(sp[4 * 33], sp[5 * 33]); o.w = cvt_pk_bf16(sp[6 * 33], sp[7 * 33]);
        *(u32x4*)(WT + (size_t)(d0 + n) * ldt + k0 + 8 * c) = o; }
    LDS_WAIT(); asm volatile("" ::: "memory");
}
template <int MODE>
__device__ __forceinline__ int transpose_row(int row_off, int n0) {
    if (MODE == 1) { const int cc = n0 < FF ? n0 : n0 - FF; return 256 * (cc >> 7) + (cc & 127) + (n0 < FF ? 0 : 128); }
    return row_off + n0;
}
template <int MODE>
__device__ __forceinline__ void transpose_matrix(const float* __restrict__ W, int K, int N, bf16* WT, int row_off, LAS float* scr, int gw, int NGW, int lane, int ldt = 0, int koff = 0, const float* __restrict__ rs = nullptr) {
    if (ldt == 0) ldt = K;
    const int nblk = N / 32, nitems = (K / 64) * nblk;
    for (int it = gw; it < nitems; it += 2 * NGW) { const int it2 = it + NGW; const bool has2 = it2 < nitems;
        const int kA = 64 * (it / nblk), nA = 32 * (it % nblk), kB = 64 * ((has2 ? it2 : it) / nblk), nB = 32 * ((has2 ? it2 : it) % nblk);
        f32x4 va[8], vb[8];
        transpose_load(W, N, kA, nA, lane, va); transpose_load(W, N, kB, nB, lane, vb);
        transpose_emit(va, WT + koff, ldt, transpose_row<MODE>(row_off, nA), scr, kA, lane, rs);
        if (has2) transpose_emit(vb, WT + koff, ldt, transpose_row<MODE>(row_off, nB), scr, kB, lane, rs); }
}

constexpr int KV_ROWB = 272, KV_BYTES = 256 * KV_ROWB, V_ROWB = 288;
__device__ __forceinline__ void attn_unit(const bf16* PA, bf16* OG, float* LSE, LAS unsigned char* lds, int unit, int tid, int w, int lane) {
    const int g = unit >> 8, rr = unit & 255, h = rr >> 6, c = rr & 63;
    const int dsh = 2 * g, dil = 1 << dsh, nblk = 64 >> dsh, n = c / nblk, b = c % nblk, hg = 4 * g + h;
    const float slope_d = exp2f(-8.f * (float)(hg + 1) / 12.f) * (float)dil;
    const int q = lane >> 4, li = lane & 15, qi = 16 * w + li;
    const size_t tq = (size_t)(128 * b + qi) * dil + n;
    {
        u32x4 v[16];
        const int ch = tid & 15, kk0 = tid >> 4;
#pragma unroll
        for (int it = 0; it < 16; ++it) { const int which = it >> 3, kk = kk0 + 32 * (it & 7), kp = 128 * (b - 1) + kk;
            v[it] = (u32x4){0u, 0u, 0u, 0u};
            if (kp >= 0) { const size_t t = (size_t)kp * dil + n; v[it] = *(const u32x4*)(PA + t * PAW + (which ? OV : OK_) + hg * 128 + ch * 8); } }
#pragma unroll
        for (int it = 0; it < 16; ++it) { const int which = it >> 3, kk = kk0 + 32 * (it & 7);
            *(LAS u32x4*)(lds + which * KV_BYTES + kk * (which ? V_ROWB : KV_ROWB) + ch * 16) = v[it]; }
    }
    bf16x8 qf[4];
#pragma unroll
    for (int s = 0; s < 4; ++s) qf[s] = *(const bf16x8*)(PA + tq * PAW + OQ + hg * 128 + 32 * s + 8 * q);
    __syncthreads();
    f32x4 sc[10];
#pragma unroll
    for (int kt = 0; kt < 10; ++kt) sc[kt] = (f32x4){0.f, 0.f, 0.f, 0.f};
#pragma unroll
    for (int g3 = 0; g3 < 3; ++g3) {
        bf16x8 kf[3][4];
#pragma unroll
        for (int j = 0; j < 3; ++j)
#pragma unroll
            for (int s = 0; s < 4; ++s) kf[j][s] = *(const LAS bf16x8*)(lds + (16 * (w + 3 * g3 + j) + li) * KV_ROWB + 64 * s + 16 * q);
        __builtin_amdgcn_sched_barrier(0);
#pragma unroll
        for (int s = 0; s < 4; ++s)
#pragma unroll
            for (int j = 0; j < 3; ++j) sc[3 * g3 + j] = __builtin_amdgcn_mfma_f32_16x16x32_bf16(kf[j][s], qf[s], sc[3 * g3 + j], 0, 0, 0);
        __builtin_amdgcn_sched_barrier(0);
    }
    const float scale = 0.08838834764831845f;
    float mx = -INFINITY;
#pragma unroll
    for (int kt = 0; kt < 9; ++kt)
#pragma unroll
        for (int e = 0; e < 4; ++e) { const int kk = 16 * (w + kt) + 4 * q + e, j = 128 + qi - kk;
            const bool valid = (j >= 0) && (j <= 128) && (b > 0 || kk >= 128);
            const float sv = valid ? sc[kt][e] * scale - slope_d * (float)j : -INFINITY;
            sc[kt][e] = sv; mx = fmaxf(mx, sv); }
    mx = fmaxf(mx, __shfl_xor(mx, 16)); mx = fmaxf(mx, __shfl_xor(mx, 32));
    float sum = 0.f;
#pragma unroll
    for (int kt = 0; kt < 9; ++kt)
#pragma unroll
        for (int e = 0; e < 4; ++e) { const float p = __expf(sc[kt][e] - mx); sc[kt][e] = p; sum += p; }
    sum += __shfl_xor(sum, 16); sum += __shfl_xor(sum, 32);
    bf16x8 pf[5];
#pragma unroll
    for (int cc = 0; cc < 5; ++cc) { u32x4 wv; wv.x = cvt_pk_bf16(sc[2 * cc][0], sc[2 * cc][1]); wv.y = cvt_pk_bf16(sc[2 * cc][2], sc[2 * cc][3]);
        wv.z = cvt_pk_bf16(sc[2 * cc + 1][0], sc[2 * cc + 1][1]); wv.w = cvt_pk_bf16(sc[2 * cc + 1][2], sc[2 * cc + 1][3]); pf[cc] = __builtin_bit_cast(bf16x8, wv); }
    f32x4 o[8];
#pragma unroll
    for (int nt = 0; nt < 8; ++nt) o[nt] = (f32x4){0.f, 0.f, 0.f, 0.f};
    const LAS unsigned char* vb = lds + KV_BYTES;
#pragma unroll
    for (int cc = 0; cc < 5; ++cc) {
        const int t0 = w + 2 * cc, t1r = w + 2 * cc + 1, t1 = t1r > 15 ? 15 : t1r;
        const int r0 = 16 * t0 + 4 * q + (li >> 2), r1 = 16 * t1 + 4 * q + (li >> 2);
        s16x4 v0[8], v1[8];
#pragma unroll
        for (int nt = 0; nt < 8; ++nt) {
            v0[nt] = __builtin_amdgcn_ds_read_tr16_b64_v4i16((LAS s16x4*)(vb + r0 * V_ROWB + (16 * nt + 4 * (li & 3)) * 2));
            v1[nt] = __builtin_amdgcn_ds_read_tr16_b64_v4i16((LAS s16x4*)(vb + r1 * V_ROWB + (16 * nt + 4 * (li & 3)) * 2)); }
        __builtin_amdgcn_sched_barrier(0);
#pragma unroll
        for (int nt = 0; nt < 8; ++nt) {
            const bf16x8 vf = {v0[nt][0], v0[nt][1], v0[nt][2], v0[nt][3], v1[nt][0], v1[nt][1], v1[nt][2], v1[nt][3]};
            o[nt] = __builtin_amdgcn_mfma_f32_16x16x32_bf16(vf, pf[cc], o[nt], 0, 0, 0); }
        __builtin_amdgcn_sched_barrier(0); }
    const float inv = 1.f / sum;
    bf16* op = OG + ((size_t)g * SEQ + tq) * 512 + h * 128 + 4 * q;
#pragma unroll
    for (int nt = 0; nt < 8; ++nt) { const f32x4 ov = o[nt] * inv; u32x2 w; w.x = cvt_pk_bf16(ov[0], ov[1]); w.y = cvt_pk_bf16(ov[2], ov[3]); *(u32x2*)(op + 16 * nt) = w; }
    if (q == 0) LSE[((size_t)g * SEQ + tq) * 4 + h] = mx + __logf(sum);
    asm volatile("s_waitcnt lgkmcnt(0)\n\ts_barrier" ::: "memory");
}

template <int W>
__device__ __forceinline__ void pool_block(const bf16* PA, bf16* POOLED, int t0, int ch) {
    u32x4 v[W + 7];
#pragma unroll
    for (int r = 0; r < W + 7; ++r) { const int t = t0 - (W - 1) + r; v[r] = (u32x4){0u, 0u, 0u, 0u}; if (t >= 0) v[r] = *(const u32x4*)(PA + (size_t)t * PAW + ch * 8); }
    float s[8];
#pragma unroll
    for (int e = 0; e < 8; ++e) s[e] = 0.f;
#pragma unroll
    for (int r = 0; r < W - 1; ++r) { s[0] += bf_lo(v[r].x); s[1] += bf_hi(v[r].x); s[2] += bf_lo(v[r].y); s[3] += bf_hi(v[r].y); s[4] += bf_lo(v[r].z); s[5] += bf_hi(v[r].z); s[6] += bf_lo(v[r].w); s[7] += bf_hi(v[r].w); }
#pragma unroll
    for (int j = 0; j < 8; ++j) { const u32x4 c = v[j + W - 1];
        const float f[8] = {bf_lo(c.x), bf_hi(c.x), bf_lo(c.y), bf_hi(c.y), bf_lo(c.z), bf_hi(c.z), bf_lo(c.w), bf_hi(c.w)};
#pragma unroll
        for (int e = 0; e < 8; ++e) s[e] += f[e];
        const int t = t0 + j, cnt = (t + 1 < W) ? t + 1 : W; const float ic = 1.f / (float)cnt;
        u32x4 o; o.x = cvt_pk_bf16(s[0] * ic - f[0], s[1] * ic - f[1]); o.y = cvt_pk_bf16(s[2] * ic - f[2], s[3] * ic - f[3]);
        o.z = cvt_pk_bf16(s[4] * ic - f[4], s[5] * ic - f[5]); o.w = cvt_pk_bf16(s[6] * ic - f[6], s[7] * ic - f[7]);
        *(u32x4*)(POOLED + (size_t)t * 1024 + ch * 8) = o;
        const u32x4 d = v[j];
        s[0] -= bf_lo(d.x); s[1] -= bf_hi(d.x); s[2] -= bf_lo(d.y); s[3] -= bf_hi(d.y); s[4] -= bf_lo(d.z); s[5] -= bf_hi(d.z); s[6] -= bf_lo(d.w); s[7] -= bf_hi(d.w); }
}

#define XB_TMO      128
#define XB_XCNT(j)  (256  + 64 * (j))
#define XB_XSUB(j)  (1280 + 64 * (j))
#define XB_XGEN(j)  (2304 + 64 * (j))
#define XB_TOP      3328
#define XB_TOPGEN   3392
#define XCD_BAR_WORDS 3456
#define XB_SPIN_CAP (1u << 18)
__device__ __forceinline__ unsigned xb_ld(unsigned* p)              { return __hip_atomic_load(p, __ATOMIC_RELAXED, __HIP_MEMORY_SCOPE_AGENT); }
__device__ __forceinline__ unsigned xb_add(unsigned* p, unsigned v) { return __hip_atomic_fetch_add(p, v, __ATOMIC_RELAXED, __HIP_MEMORY_SCOPE_AGENT); }
__device__ __forceinline__ unsigned xb_xcc_id() { return (unsigned)__builtin_amdgcn_s_getreg((3 << 11) | 20) & 0xFu; }
#define XB_SPIN(cond, bar) do { unsigned _sp = 0; while (cond) { __builtin_amdgcn_s_sleep(1); \
    if ((++_sp & 255u) == 0u) { if (xb_ld(&(bar)[XB_TMO])) break; if (_sp > XB_SPIN_CAP) { atomicAdd(&(bar)[XB_TMO], 1u); break; } } } } while (0)
struct XcdBarrier { unsigned* bar; unsigned x; volatile LAS unsigned* st; };
__device__ __forceinline__ XcdBarrier xcd_barrier_post(unsigned* bar, volatile LAS unsigned* st) {
    XcdBarrier b; b.bar = bar; b.x = xb_xcc_id(); b.st = st;
    if (threadIdx.x == 0) (void)xb_add(&bar[XB_XCNT(b.x)], 1u);
    return b;
}
__device__ __forceinline__ void xcd_barrier_complete(unsigned* bar, unsigned x, unsigned& nloc, unsigned& nx) {
    const unsigned G = gridDim.x * gridDim.y * gridDim.z;
    unsigned sum, cnt, mine, sp = 0u;
    for (;;) {
        sum = 0u; cnt = 0u; mine = 0u;
#pragma unroll
        for (unsigned j = 0; j < 16; ++j) { const unsigned c = xb_ld(&bar[XB_XCNT(j)]); sum += c; cnt += (c > 0u) ? 1u : 0u; mine = (j == x) ? c : mine; }
        if (sum == G) break;
        __builtin_amdgcn_s_sleep(1);
        if ((++sp & 255u) == 0u) { if (xb_ld(&bar[XB_TMO])) break; if (sp > XB_SPIN_CAP) { atomicAdd(&bar[XB_TMO], 1u); break; } }
    }
    nloc = mine > 0u ? mine : 1u; nx = cnt > 0u ? cnt : 1u;
}
__device__ __forceinline__ void xcd_barrier(const XcdBarrier& b) {
    asm volatile("s_waitcnt vmcnt(0)" ::: "memory");
    __syncthreads();
    if (threadIdx.x == 0) {
        unsigned* bar = b.bar;
        __builtin_amdgcn_s_waitcnt(0);
        unsigned nloc = b.st[0], nx = b.st[1];
        if (nloc == 0u) { xcd_barrier_complete(bar, b.x, nloc, nx); b.st[0] = nloc; b.st[1] = nx; }
        const unsigned old = xb_add(&bar[XB_XSUB(b.x)], 1u);
        const unsigned gen = old / nloc;
        if (old + 1u == (gen + 1u) * nloc) {
            __builtin_amdgcn_fence(__ATOMIC_RELEASE, "agent");
            asm volatile("s_waitcnt vmcnt(0)" ::: "memory");
            const unsigned og = xb_add(&bar[XB_TOP], 1u);
            const unsigned tg = og / nx;
            if (og + 1u == (tg + 1u) * nx) xb_add(&bar[XB_TOPGEN], 1u);
            else XB_SPIN(xb_ld(&bar[XB_TOPGEN]) == tg, bar);
            __builtin_amdgcn_fence(__ATOMIC_ACQUIRE, "agent");
            asm volatile("s_waitcnt vmcnt(0)" ::: "memory");
        } else {
            XB_SPIN(xb_ld(&bar[XB_TOPGEN]) == gen, bar);
            __builtin_amdgcn_fence(__ATOMIC_ACQUIRE, "agent");
            asm volatile("s_waitcnt vmcnt(0)" ::: "memory");
        }
    }
    __syncthreads();
}

struct Args { const float* in[15]; float* out; unsigned char* ws; int ph_lo, ph_hi; };
constexpr int N_PHASES = 9;

__global__ void __launch_bounds__(NT, 2) fwd_megakernel(Args args) {
    extern __shared__ __attribute__((aligned(16))) unsigned char lds_raw[];
    LAS unsigned char* lds = (LAS unsigned char*)lds_raw;
    cg::grid_group grid = cg::this_grid();
    const int tid = threadIdx.x, lane = tid & 63, wave = __builtin_amdgcn_readfirstlane(tid >> 6);
    const int G = gridDim.x, bx = blockIdx.x;
    const int vcu = (G % 8 == 0) ? (bx % 8) * (G / 8) + bx / 8 : bx;
    const int gw = vcu * NWAVES + wave, NGW = G * NWAVES;
    const size_t gt = (size_t)bx * NT + tid, NGT = (size_t)G * NT;
    unsigned char* ws = args.ws;
    const float* x = args.in[0]; const float* g_mix = args.in[1]; const float* w_in = args.in[2]; const float* b_gate = args.in[3];
    const float* w_pool_lin = args.in[4]; const float* pool_scale = args.in[5]; const float* w_pool_out = args.in[6]; const float* w_attn_out = args.in[7];
    const float* w_out = args.in[8]; const float* g_ffn = args.in[9]; const float* w_up = args.in[10]; const float* conv_w = args.in[11];
    const float* conv_b = args.in[12]; const float* w_down = args.in[13]; const float* g_final = args.in[14];
    float* out = args.out;
    float* RSTD1 = (float*)(ws + WS_RSTD);
    float* SSQ1 = (float*)(ws + WS_SSQ1); float* SSQ2 = (float*)(ws + WS_SSQ2); float* LSE = (float*)(ws + WS_LSE);
    bf16* WUP = (bf16*)(ws + WS_WUP); bf16* WDN = (bf16*)(ws + WS_WDN); bf16* WOUT = (bf16*)(ws + WS_WOUT); bf16* WPO = (bf16*)(ws + WS_WPO);
    bf16* WAO = (bf16*)(ws + WS_WAO); bf16* WPL = (bf16*)(ws + WS_WPL); bf16* WIN = (bf16*)(ws + WS_WIN); bf16* H = (bf16*)(ws + WS_H);
    bf16* PA = (bf16*)(ws + WS_PA); bf16* GATES = (bf16*)(ws + WS_GATES); bf16* POOLED = (bf16*)(ws + WS_POOLED); bf16* PM = (bf16*)(ws + WS_PM);
    bf16* AO = (bf16*)(ws + WS_AO); bf16* OG = (bf16*)(ws + WS_OG); float* T = (float*)(ws + WS_T); bf16* MIXED = (bf16*)(ws + WS_MIXED);
    bf16* XB = (bf16*)(ws + WS_XB); bf16* ACT = (bf16*)(ws + WS_ACT);
    const int lo = args.ph_lo, hi = args.ph_hi;
    if (hi > N_PHASES) grid.sync();
    if (tid < 2) ((volatile LAS unsigned*)(lds + BARST_OFF))[tid] = 0u;
    __syncthreads();
    const XcdBarrier xbar = xcd_barrier_post((unsigned*)(ws + WS_BAR), (volatile LAS unsigned*)(lds + BARST_OFF));
#ifndef PH_MASK
#define PH_MASK 0x1ff
#endif
#define IN(k) (((PH_MASK >> (k)) & 1) && lo <= (k) && (k) < hi)
#define SEAM(k) do { if (IN(k) && IN((k) + 1)) { xcd_barrier(xbar); } } while (0)

    if (IN(0)) {
        LAS float* scr = (LAS float*)(lds + wave * 16384);
        transpose_matrix<0>(w_in, DM, INW, WIN, 0, scr, gw, NGW, lane);
        { const f32x4* gr = (const f32x4*)g_mix + lane;
          f32x4 gg[8];
#pragma unroll
          for (int j = 0; j < 8; ++j) gg[j] = gr[64 * j];
          for (int m = gw; m < SEQ; m += 2 * NGW) { const int m2 = m + NGW; const bool has2 = m2 < SEQ;
            const f32x4* xr = (const f32x4*)(x + (size_t)m * DM) + lane; const f32x4* xr2 = (const f32x4*)(x + (size_t)(has2 ? m2 : m) * DM) + lane;
            f32x4 v[8], v2[8]; float s = 0.f, s2 = 0.f;
#pragma unroll
            for (int j = 0; j < 8; ++j) { v[j] = __builtin_nontemporal_load(xr + 64 * j); v2[j] = __builtin_nontemporal_load(xr2 + 64 * j); }
#pragma unroll
            for (int j = 0; j < 8; ++j) { s += (v[j].x * v[j].x + v[j].y * v[j].y) + (v[j].z * v[j].z + v[j].w * v[j].w); s2 += (v2[j].x * v2[j].x + v2[j].y * v2[j].y) + (v2[j].z * v2[j].z + v2[j].w * v2[j].w); }
            const float rstd = __builtin_amdgcn_rsqf(wave_sum(s) * (1.f / DM) + RMS_EPS), rstd2 = __builtin_amdgcn_rsqf(wave_sum(s2) * (1.f / DM) + RMS_EPS);
            u32x2* o8 = (u32x2*)(H + (size_t)m * DM) + lane; u32x2* o82 = (u32x2*)(H + (size_t)(has2 ? m2 : m) * DM) + lane;
#pragma unroll
            for (int j = 0; j < 8; ++j) { u32x2 o; o.x = cvt_pk_bf16(v[j].x * rstd * gg[j].x, v[j].y * rstd * gg[j].y); o.y = cvt_pk_bf16(v[j].z * rstd * gg[j].z, v[j].w * rstd * gg[j].w); o8[64 * j] = o; }
            if (has2) {
#pragma unroll
              for (int j = 0; j < 8; ++j) { u32x2 o; o.x = cvt_pk_bf16(v2[j].x * rstd2 * gg[j].x, v2[j].y * rstd2 * gg[j].y); o.y = cvt_pk_bf16(v2[j].z * rstd2 * gg[j].z, v2[j].w * rstd2 * gg[j].w); o82[64 * j] = o; } }
          } }
        __syncthreads();
    }
    SEAM(0);

    if (IN(1)) {
        pg8::Gemm g{H, WIN, DM, DM, DM, 0}; pg8::StaticOrder S; S.init(SEQ / 256, INW / 256, G, bx);
        pg8::EpiProj E{PA, GATES, b_gate};
        pg8::gemm_phase<pg8::EpiProj, false>(lds, g, S, E);
        LAS float* scr = (LAS float*)(lds + wave * 16384);
        { const int nu = (SEQ / 256) * (INW / 256), rounds = (nu + G - 1) / G, busy = nu - (rounds - 1) * G, nidle = G - busy;
          const bool all = (nidle < 16); const int cgw = all ? gw : (bx - busy) * NWAVES + wave, cngw = all ? NGW : nidle * NWAVES;
          if (all || bx >= busy) {
            for (int gi = 0; gi < 4; ++gi) transpose_matrix<0>(w_pool_lin + (size_t)gi * 65536, 256, 256, WPL, 256 * gi, scr, cgw, cngw, lane);
            transpose_matrix<0>(w_pool_out, 1024, DM, WPO, 0, scr, cgw, cngw, lane, 1536, 0);
            transpose_matrix<0>(w_attn_out, 512, DM, WPO, 0, scr, cgw, cngw, lane, 1536, 1024);
            transpose_matrix<0>(w_out, DM, DM, WOUT, 0, scr, cgw, cngw, lane); } }
    }
    SEAM(1);

    if (IN(2)) {
        for (int u = bx; u < 768; u += G) attn_unit(PA, OG, LSE, lds, u, tid, wave, lane);
        for (size_t idx = gt; idx < (size_t)SEQ * 16; idx += NGT) { const int c32 = (int)(idx & 31), t0 = 8 * (int)((idx >> 5) & 1023), gi = (int)(idx >> 15);
            if (gi == 0) pool_block<2>(PA, POOLED, t0, c32); else if (gi == 1) pool_block<4>(PA, POOLED, t0, 32 + c32);
            else if (gi == 2) pool_block<8>(PA, POOLED, t0, 64 + c32); else pool_block<16>(PA, POOLED, t0, 96 + c32); }
    }
    SEAM(2);

    if (IN(3)) {
        const int p3u = (SEQ / 256) * 4; const bool p3split = (G >= p3u + 64);
        const size_t cgt = p3split ? (size_t)(bx - p3u) * NT + tid : gt, cngt = p3split ? (size_t)(G - p3u) * NT : NGT;
        if (!p3split || bx >= p3u)
        for (size_t base = cgt; base < (size_t)SEQ * 128; base += 4 * cngt) {
            float l[4][3]; f32x4 a[4][3];
#pragma unroll
            for (int k = 0; k < 4; ++k) { const size_t idx = base + (size_t)k * cngt; const bool ok = idx < (size_t)SEQ * 128; const size_t t = ok ? (idx >> 7) : 0; const int c4 = (int)(idx & 127), hd = c4 >> 5;
#pragma unroll
                for (int gq = 0; gq < 3; ++gq) { l[k][gq] = LSE[((size_t)gq * SEQ + t) * 4 + hd]; { const u32x2 w = *(const u32x2*)(OG + ((size_t)gq * SEQ + t) * 512 + c4 * 4); a[k][gq] = (f32x4){bf_lo(w.x), bf_hi(w.x), bf_lo(w.y), bf_hi(w.y)}; } } }
#pragma unroll
            for (int k = 0; k < 4; ++k) { const size_t idx = base + (size_t)k * cngt; if (idx >= (size_t)SEQ * 128) continue; const size_t t = idx >> 7; const int c4 = (int)(idx & 127);
                const float m = fmaxf(l[k][0], fmaxf(l[k][1], l[k][2])); const float e0 = __expf(l[k][0] - m), e1 = __expf(l[k][1] - m), e2 = __expf(l[k][2] - m); const float is = 1.f / (e0 + e1 + e2);
                const f32x4 y = (a[k][0] * e0 + a[k][1] * e1 + a[k][2] * e2) * is;
                u32x2 o; o.x = cvt_pk_bf16(y.x, y.y); o.y = cvt_pk_bf16(y.z, y.w);
                *(u32x2*)(PM + t * 1536 + 1024 + c4 * 4) = o; } }
        pg8::Gemm g{POOLED, WPL, 1024, 256, 256, 512}; pg8::StaticOrder S; S.init(SEQ / 256, 4, G, bx);
        pg8::EpiScale E{PM, 1536, pool_scale};
        pg8::gemm_phase<pg8::EpiScale, false>(lds, g, S, E);
    }
    SEAM(3);

    if (IN(4)) {
        pg8::StaticOrder S; S.init(SEQ / 256, DM / 256, G, bx);
        { pg8::Gemm g{PM, WPO, 1536, 1536, 1536, 0}; pg8::EpiGateCat E{GATES, MIXED}; pg8::gemm_phase<pg8::EpiGateCat, false>(lds, g, S, E); }
    }
    SEAM(4);

    if (IN(5)) {
        pg8::Gemm g{MIXED, WOUT, DM, DM, DM, 0}; pg8::StaticOrder S; S.init(SEQ / 256, DM / 256, G, bx);
        if (bx == 0) { for (int i = tid; i < 2 * DM / 2; i += NT) ((unsigned*)XB)[i] = 0u;
            if (tid < 2) RSTD1[tid] = 0.f; if (tid < XB_ROWS - SEQ - 2) RSTD1[SEQ + 2 + tid] = 0.f; }
        pg8::EpiResSsq<true> E{x, out, XB, g_ffn, SSQ1, (LAS float*)(lds + RED_OFF), (unsigned*)(ws + WS_BAR) + XCD_BAR_WORDS + 34 * 64, RSTD1, (G >= 256) ? 0 : 1};
        pg8::gemm_phase<pg8::EpiResSsq<true>, false>(lds, g, S, E);
        LAS float* scr = (LAS float*)(lds + wave * 16384);
        transpose_matrix<1>(w_up, DM, FF2, WUP, 0, scr, gw, NGW, lane, 0, 0, g_ffn);
    }
    SEAM(5);

    if (IN(6)) {
        pg8::Gemm g{XB, WUP, DM, DM, DM, 0}; pg8::StaticOrder S; S.init(33, FF2 / 256, G, bx);
        pg8::EpiConvGelu E{ACT, RSTD1, conv_w, conv_b, (LAS float*)(lds + RED_OFF)};
        pg8::gemm_phase<pg8::EpiConvGelu, true>(lds, g, S, E);
        LAS float* scr = (LAS float*)(lds + wave * 16384);
        { const int nu = 33 * (FF2 / 256), rounds = (nu + G - 1) / G, busy = nu - (rounds - 1) * G, nidle = G - busy;
          const bool all = (nidle < 16); const int cgw = all ? gw : (bx - busy) * NWAVES + wave, cngw = all ? NGW : nidle * NWAVES;
          if (all || bx >= busy) transpose_matrix<0>(w_down, FF, DM, WDN, 0, scr, cgw, cngw, lane); }
    }
    SEAM(6);

    const bool fuse_norm = (G >= 256);
    if (IN(7)) {
        pg8::Gemm g{ACT, WDN, FF, FF, FF, 0}; pg8::StaticOrder S; S.init(SEQ / 256, DM / 256, G, bx);
        if (fuse_norm) { pg8::EpiResNorm E{out, g_final, SSQ2, (unsigned*)(ws + WS_BAR) + XCD_BAR_WORDS, (LAS float*)(lds + RED_OFF), XB};
            pg8::gemm_phase<pg8::EpiResNorm, false>(lds, g, S, E); }
        else { pg8::EpiResSsq<false> E{out, out, nullptr, nullptr, SSQ2, (LAS float*)(lds + RED_OFF), nullptr, nullptr, 1};
            pg8::gemm_phase<pg8::EpiResSsq<false>, false>(lds, g, S, E); }
    }
    if (!fuse_norm) SEAM(7);

    if (IN(8) && !fuse_norm) {
        for (int m = gw; m < SEQ; m += NGW) {
            float s = 0.f;
#pragma unroll
            for (int p = 0; p < 8; ++p) s += SSQ2[p * SEQ + m];
            const float rstd = __builtin_amdgcn_rsqf(s * (1.f / DM) + RMS_EPS);
            f32x4* xr = (f32x4*)(out + (size_t)m * DM) + lane; const f32x4* gr = (const f32x4*)g_final + lane;
#pragma unroll
            for (int j = 0; j < 8; ++j) { const f32x4 v = xr[64 * j], gg = gr[64 * j]; xr[64 * j] = v * rstd * gg; }
        }
    }
#undef IN
#undef SEAM
}

extern "C" void kernel_launch(void* const* d_in, const int* in_sizes, int n_in, void* d_out, int out_size, void* d_ws, size_t ws_size, hipStream_t stream) {
    static int grid = 0;
    if (grid == 0) {
        if (n_in != 15 || in_sizes[0] != SEQ * DM || out_size != SEQ * DM || ws_size < WS_END) {
            fprintf(stderr, "kernel_launch: unexpected shapes (n_in %d, in0 %d, out %d, ws %zu; need ws >= %zu)\n", n_in, n_in > 0 ? in_sizes[0] : -1, out_size, ws_size, (size_t)WS_END); grid = -1; return; }
        int dev = 0, cus = 0, per_cu = 0;
        if (hipGetDevice(&dev) != hipSuccess || hipDeviceGetAttribute(&cus, hipDeviceAttributeMultiprocessorCount, dev) != hipSuccess) { grid = -1; return; }
        if (hipFuncSetAttribute((const void*)fwd_megakernel, hipFuncAttributeMaxDynamicSharedMemorySize, LDS_BYTES) != hipSuccess) { fprintf(stderr, "kernel_launch: hipFuncSetAttribute failed\n"); grid = -1; return; }
        if (hipOccupancyMaxActiveBlocksPerMultiprocessor(&per_cu, (const void*)fwd_megakernel, NT, LDS_BYTES) != hipSuccess || per_cu < 1) { fprintf(stderr, "kernel_launch: occupancy query says %d\n", per_cu); per_cu = 1; }
        (void)hipGetLastError();
        grid = cus;
    }
    if (grid < 0) return;
    if (hipMemsetAsync((char*)d_ws + WS_BAR, 0, (XCD_BAR_WORDS + 66 * 64) * 4, stream) != hipSuccess) { fprintf(stderr, "kernel_launch: memset failed\n"); return; }
    Args a{};
    for (int i = 0; i < 15; ++i) a.in[i] = (const float*)d_in[i];
    a.out = (float*)d_out; a.ws = (unsigned char*)d_ws; a.ph_lo = 0; a.ph_hi = N_PHASES;
    void* kargs[] = {&a};
#ifdef PROBE_LO
    a.ph_lo = PROBE_LO; a.ph_hi = PROBE_HI;
    (void)hipLaunchCooperativeKernel((const void*)fwd_megakernel, dim3(grid), dim3(NT), kargs, LDS_BYTES, stream);
    a.ph_lo = 0; a.ph_hi = N_PHASES;
    (void)hipMemsetAsync((char*)d_ws + WS_BAR, 0, (XCD_BAR_WORDS + 66 * 64) * 4, stream);
#endif
    hipError_t e = hipLaunchCooperativeKernel((const void*)fwd_megakernel, dim3(grid), dim3(NT), kargs, LDS_BYTES, stream);
#ifdef PROBE_AFTER_LO
    a.ph_lo = PROBE_AFTER_LO; a.ph_hi = PROBE_AFTER_HI;
    (void)hipLaunchCooperativeKernel((const void*)fwd_megakernel, dim3(grid), dim3(NT), kargs, LDS_BYTES, stream);
#endif
    if (e != hipSuccess) fprintf(stderr, "kernel_launch: cooperative launch failed: %s (grid %d)\n", hipGetErrorString(e), grid);
}
```

```cpp
#include <hip/hip_runtime.h>
#include <hip/hip_cooperative_groups.h>
#include <cstdio>
#include <cstdint>
namespace cg = cooperative_groups;

#define LAS __attribute__((address_space(3)))
typedef unsigned short bf16;
typedef short bf16x8 __attribute__((ext_vector_type(8)));
typedef short s16x4 __attribute__((ext_vector_type(4)));
typedef float f32x4 __attribute__((ext_vector_type(4)));
typedef float f32x2 __attribute__((ext_vector_type(2)));
typedef unsigned u32x4 __attribute__((ext_vector_type(4)));
typedef unsigned u32x2 __attribute__((ext_vector_type(2)));

constexpr int SEQ = 8192, DM = 2048, INW = 9728, PAW = 5632  , GWD = 4096  , FF = 5632, FF2 = 11264;
constexpr int OQ = 1024, OK_ = 2560, OV = 4096;
constexpr float RMS_EPS = 1e-6f;
constexpr int XB_ROWS = 8320;
constexpr int NT = 512, NWAVES = 8;

constexpr size_t MiB = 1u << 20;
constexpr size_t WS_SSQ1 = 0, WS_SSQ2 = 256 * 1024, WS_LSE = 512 * 1024;
constexpr size_t WS_WUP = 2 * MiB, WS_WDN = 46 * MiB, WS_WOUT = 68 * MiB, WS_WPO = 76 * MiB, WS_WAO = 80 * MiB, WS_WPL = 82 * MiB;
constexpr size_t WS_WIN = 83 * MiB, WS_H = 121 * MiB;
constexpr size_t WS_PA = 153 * MiB, WS_GATES = 241 * MiB;
constexpr size_t WS_POOLED = 305 * MiB, WS_PM = 321 * MiB, WS_AO = 337 * MiB;
constexpr size_t WS_OG = 83 * MiB;
constexpr size_t WS_T = 153 * MiB;
constexpr size_t WS_MIXED = 83 * MiB;
constexpr size_t WS_XB = 115 * MiB;
constexpr size_t WS_ACT = 153 * MiB;
constexpr size_t WS_END = 345 * MiB;

constexpr size_t WS_RSTD = 896 * 1024;
constexpr size_t WS_BAR = 1 * MiB;
constexpr int LDS_BYTES = 147456, RED_OFF = 131072, BARST_OFF = 147392;

#define LDS_WAIT() asm volatile("s_waitcnt lgkmcnt(0)" ::: "memory")

__device__ __forceinline__ unsigned cvt_pk_bf16(float lo, float hi) { unsigned r; asm volatile("v_cvt_pk_bf16_f32 %0, %1, %2" : "=v"(r) : "v"(lo), "v"(hi)); return r; }
__device__ __forceinline__ float bf_lo(unsigned w) { return __builtin_bit_cast(float, w << 16); }
__device__ __forceinline__ float bf_hi(unsigned w) { return __builtin_bit_cast(float, w & 0xffff0000u); }
__device__ __forceinline__ float wave_sum(float v) {
#pragma unroll
    for (int o = 1; o < 64; o <<= 1) v += __shfl_xor(v, o);
    return v;
}
__device__ __forceinline__ f32x2 gelu_pk(f32x2 v) {
    const f32x2 av = __builtin_elementwise_abs(v), d = av * 0.2316418882f + 1.0f;
    f32x2 t; t.x = __builtin_amdgcn_rcpf(d.x); t.y = __builtin_amdgcn_rcpf(d.y);
    f32x2 q = t * 0.5307027145f + (-0.7265760135f); q = q * t + 0.7107068705f; q = q * t + (-0.142248368f); q = q * t + 0.127414796f; q = q * t;
    const f32x2 s = (v * v) * (-0.72134752044f);
    f32x2 e; e.x = __builtin_amdgcn_exp2f(s.x); e.y = __builtin_amdgcn_exp2f(s.y);
    const f32x2 m = v * (q * e), r = v - m;
    f32x2 o; o.x = v.x < 0.f ? m.x : r.x; o.y = v.y < 0.f ? m.y : r.y; return o;
}
__device__ __forceinline__ f32x2 gelu_pk2(f32x2 v) {
    const f32x2 ax = __builtin_elementwise_abs(v) * 0.70710678f;
    f32x2 p = ax * 0.0000430638f + 0.0002765672f; p = p * ax + 0.0001520143f; p = p * ax + 0.0092705272f; p = p * ax + 0.0422820123f; p = p * ax + 0.0705230784f; p = p * ax + 1.0f;
    p = p * p; p = p * p; p = p * p; p = p * p;
    f32x2 r; r.x = __builtin_amdgcn_rcpf(p.x); r.y = __builtin_amdgcn_rcpf(p.y);
    const f32x2 m = (v * 0.5f) * r, q = v - m;
    f32x2 o; o.x = v.x < 0.f ? m.x : q.x; o.y = v.y < 0.f ? m.y : q.y; return o;
}
__device__ __forceinline__ f32x2 gelu_pk3(f32x2 v) {
    const f32x2 av = __builtin_elementwise_abs(v), ax = av * 0.70710678f;
    f32x2 p = ax * 0.0000430638f + 0.0002765672f; p = p * ax + 0.0001520143f; p = p * ax + 0.0092705272f; p = p * ax + 0.0422820123f; p = p * ax + 0.0705230784f; p = p * ax + 1.0f;
    p = p * p; p = p * p; p = p * p; p = p * p;
    f32x2 r; r.x = __builtin_amdgcn_rcpf(p.x); r.y = __builtin_amdgcn_rcpf(p.y);
    return ((v + av) - av * r) * 0.5f;
}
__device__ __forceinline__ float sigmoidf_(float z) { return __builtin_amdgcn_rcpf(1.f + __expf(-z)); }

namespace pg8 {
typedef unsigned short bf16_t;
constexpr int BM = 256, BK = 64, HALF = 128, HTB = HALF * BK * 2, NXCD = 8, WGM = 4;

__host__ __device__ __forceinline__ int lds_byte(int r, int c) { const int st = (r >> 4) * 2 + (c >> 5), rr = r & 15, cc = c & 31, ob = rr * 64 + cc * 2; return st * 1024 + (ob ^ (((ob >> 9) & 1) << 5)); }
__host__ __device__ __forceinline__ void stage_rc(int b, int& R, int& C) { const int st = b / 1024, sb = b % 1024, swz = sb ^ (((sb >> 9) & 1) << 5); R = (st >> 1) * 16 + swz / 64; C = (st & 1) * 32 + (swz % 64) / 2; }
__host__ __device__ __forceinline__ int perm32(int rho) { const int n = rho >> 4, i = rho & 15; return 8 * (i >> 2) + 4 * n + (i & 3); }

struct Unit { int pm, pn; };
struct Gemm { const bf16_t* A; const bf16_t* Bt; int lda, ldb, K, a_pn_off; };

struct StaticOrder {
    int nM, nN, nwg, G, c;
    __host__ __device__ void init(int nM_, int nN_, int G_, int c_) { nM = nM_; nN = nN_; nwg = nM * nN; G = G_; c = c_; }
    __host__ __device__ bool next(int i, Unit& u) const {
        const long L = (long)i * G + c; if (L >= nwg) return false;
        int wgid = (int)L; { const int q = nwg / NXCD, r = nwg % NXCD, xcd = wgid % NXCD, off = wgid / NXCD; wgid = (xcd < r ? xcd * (q + 1) : r * (q + 1) + (xcd - r) * q) + off; }
        const int nig = WGM * nN, gid = wgid / nig, fm = gid * WGM, gsz = (nM - fm) < WGM ? (nM - fm) : WGM;
        u.pm = fm + ((wgid % nig) % gsz); u.pn = (wgid % nig) / gsz; return true;
    }
};

template <class Epi, bool CONV>
__device__ __forceinline__ void gemm_phase(LAS unsigned char* lds, const Gemm g, const StaticOrder& S, const Epi& E) {
    const int tid = threadIdx.x, wid = __builtin_amdgcn_readfirstlane(tid >> 6), lane = tid & 63, wr = wid >> 2, wc = wid & 3, fr = lane & 15, fq = lane >> 4;
    const int K = g.K, nt = K / BK;
    unsigned voffA[2], voffB[2];
#pragma unroll
    for (int i = 0; i < 2; ++i) { int R, C; stage_rc(tid * 16 + i * 8192, R, C); const int Rb = (R & ~31) + perm32(R & 31);
        const int Ra = CONV ? (126 * (R >> 6) + 8 * (R & 15) + ((R >> 4) & 3)) : R;
        voffA[i] = (unsigned)(Ra * g.lda + C) * 2u; voffB[i] = (unsigned)(Rb * g.ldb + C) * 2u; }
    const size_t kstep = (size_t)(BK * 2);
    const size_t hstepA = (size_t)(CONV ? 4 : HALF) * g.lda * 2, hstepB = (size_t)HALF * g.ldb * 2;
    const size_t tstepA = (size_t)(CONV ? 252 : 256) * g.lda * 2, tstepB = (size_t)256 * g.ldb * 2;
    const unsigned ldsw = (unsigned)wid * 1024u;
    const int aoff = lds_byte(wr * 64 + fr, fq * 8), boff = lds_byte(wc * 32 + fr, fq * 8);
#define PG8_SA(b, h) (((b) * 2 + (h)) * HTB)
#define PG8_SB(b, h) ((4 + (b) * 2 + (h)) * HTB)
#define PG8_STAGE(bufoff, gbase, voff) do { _Pragma("unroll") for (int _i = 0; _i < 2; ++_i) \
        __builtin_amdgcn_global_load_lds((const unsigned*)((const char*)(gbase) + (voff)[_i]), (LAS unsigned*)(lds + (bufoff) + ldsw + _i * 8192), 16, 0, 0); } while (0)
#define PG8_LDA(dst, b, h) do { _Pragma("unroll") for (int m = 0; m < 4; ++m) _Pragma("unroll") for (int k = 0; k < 2; ++k) dst[m][k] = *(const LAS bf16x8*)(lds + PG8_SA(b, h) + aoff + m * 2048 + k * 1024); } while (0)
#define PG8_LDB(dst, b, h) do { _Pragma("unroll") for (int n = 0; n < 2; ++n) _Pragma("unroll") for (int k = 0; k < 2; ++k) dst[n][k] = *(const LAS bf16x8*)(lds + PG8_SB(b, h) + boff + n * 2048 + k * 1024); } while (0)
#define PG8_MMA(ai, bj, At, Bt) do { __builtin_amdgcn_s_setprio(1); _Pragma("unroll") for (int m = 0; m < 4; ++m) _Pragma("unroll") for (int n = 0; n < 2; ++n) _Pragma("unroll") for (int k = 0; k < 2; ++k) \
        acc[ai][bj][m][n] = __builtin_amdgcn_mfma_f32_16x16x32_bf16(Bt[n][k], At[m][k], acc[ai][bj][m][n], 0, 0, 0); __builtin_amdgcn_s_setprio(0); } while (0)
#define PG8_WAIT_V(n) asm volatile("s_waitcnt vmcnt(" #n ")" ::: "memory")
#define PG8_WAIT_L(n) asm volatile("s_waitcnt lgkmcnt(" #n ")" ::: "memory")
#define PG8_BAR __builtin_amdgcn_s_barrier()
#define PG8_SCHED __builtin_amdgcn_sched_barrier(0)
    Unit cur, nxt; int ui = 0;
    if (!S.next(0, cur)) return;
    f32x4 acc[2][2][4][2];
#pragma unroll
    for (int a = 0; a < 2; ++a)
#pragma unroll
        for (int b = 0; b < 2; ++b)
#pragma unroll
            for (int m = 0; m < 4; ++m)
#pragma unroll
                for (int n = 0; n < 2; ++n) acc[a][b][m][n] = (f32x4){0.f, 0.f, 0.f, 0.f};
    bf16x8 At[4][2], B0[2][2], B1[2][2];
    f32x4 epre = {0.f, 0.f, 0.f, 0.f};
    const char* cA = (const char*)g.A + (size_t)cur.pm * tstepA + (size_t)cur.pn * g.a_pn_off; const char* cB = (const char*)g.Bt + (size_t)cur.pn * tstepB;
    PG8_STAGE(PG8_SB(0, 0), cB, voffB); PG8_STAGE(PG8_SB(0, 1), cB + hstepB, voffB); PG8_STAGE(PG8_SA(0, 0), cA, voffA); PG8_STAGE(PG8_SA(0, 1), cA + hstepA, voffA);
    if (wr == 1) PG8_BAR;
    PG8_WAIT_V(2); PG8_BAR;
    PG8_STAGE(PG8_SB(1, 0), cB + kstep, voffB); PG8_STAGE(PG8_SA(1, 0), cA + kstep, voffA); PG8_STAGE(PG8_SB(1, 1), cB + hstepB + kstep, voffB);
    PG8_WAIT_V(6); PG8_BAR;
    for (;;) {
        const bool has_next = S.next(ui + 1, nxt);
        const char* nA = has_next ? (const char*)g.A + (size_t)nxt.pm * tstepA + (size_t)nxt.pn * g.a_pn_off : cA; const char* nB = has_next ? (const char*)g.Bt + (size_t)nxt.pn * tstepB : cB;
#define PG8_KBODY(t) do { \
            const bool last = (t == nt - 2); \
            if constexpr (Epi::PRE) { if (last) epre = E.pre(cur); } \
            const char* a1 = cA + (size_t)(t + 1) * kstep; \
            const char* a2 = last ? nA : cA + (size_t)(t + 2) * kstep; const char* b2 = last ? nB : cB + (size_t)(t + 2) * kstep; \
            const char* a3 = a2 + kstep; const char* b3 = b2 + kstep; \
            PG8_LDB(B0, 0, 0); PG8_LDB(B1, 0, 1); PG8_SCHED; PG8_LDA(At, 0, 0); PG8_STAGE(PG8_SA(1, 1), a1 + hstepA, voffA); \
            PG8_WAIT_V(8); PG8_WAIT_L(0); PG8_BAR; PG8_MMA(0, 0, At, B0); PG8_MMA(0, 1, At, B1); PG8_BAR; PG8_SCHED; \
            PG8_LDA(At, 0, 1); PG8_STAGE(PG8_SB(0, 0), b2, voffB); PG8_STAGE(PG8_SB(0, 1), b2 + hstepB, voffB); PG8_STAGE(PG8_SA(0, 0), a2, voffA); \
            PG8_WAIT_V(8); PG8_WAIT_L(0); PG8_BAR; PG8_MMA(1, 0, At, B0); PG8_MMA(1, 1, At, B1); PG8_BAR; PG8_SCHED; \
            PG8_LDB(B0, 1, 0); PG8_LDB(B1, 1, 1); PG8_SCHED; PG8_LDA(At, 1, 0); PG8_STAGE(PG8_SA(0, 1), a2 + hstepA, voffA); \
            PG8_WAIT_V(8); PG8_WAIT_L(0); PG8_BAR; PG8_MMA(0, 0, At, B0); PG8_MMA(0, 1, At, B1); PG8_BAR; PG8_SCHED; \
            PG8_LDA(At, 1, 1); PG8_STAGE(PG8_SB(1, 0), b3, voffB); PG8_STAGE(PG8_SB(1, 1), b3 + hstepB, voffB); PG8_STAGE(PG8_SA(1, 0), a3, voffA); \
            PG8_WAIT_V(8); PG8_WAIT_L(0); PG8_BAR; PG8_MMA(1, 0, At, B0); PG8_MMA(1, 1, At, B1); PG8_BAR; PG8_SCHED; \
        } while (0)
        if constexpr (Epi::TSPLIT >= 0) {
#pragma unroll 1
            for (int t = 0; t < Epi::TSPLIT; t += 2) PG8_KBODY(t);
            E.mid(acc, cur, wr, wc, fr, fq);
#pragma unroll 1
            for (int t = Epi::TSPLIT; t < nt; t += 2) PG8_KBODY(t);
        } else {
#pragma unroll 1
            for (int t = 0; t < nt; t += 2) PG8_KBODY(t);
        }
#undef PG8_KBODY
        if (wr == 0) PG8_BAR;
        if constexpr (Epi::PRE) E(acc, cur, wr, wc, fr, fq, epre); else E(acc, cur, wr, wc, fr, fq);
        if (!has_next) break;
#pragma unroll
        for (int a = 0; a < 2; ++a)
#pragma unroll
            for (int b = 0; b < 2; ++b)
#pragma unroll
                for (int m = 0; m < 4; ++m)
#pragma unroll
                    for (int n = 0; n < 2; ++n) acc[a][b][m][n] = (f32x4){0.f, 0.f, 0.f, 0.f};
        cur = nxt; cA = nA; cB = nB; ++ui;
        if (wr == 1) PG8_BAR;
    }
    PG8_WAIT_V(0);
    PG8_BAR;
#undef PG8_SA
#undef PG8_SB
#undef PG8_STAGE
#undef PG8_LDA
#undef PG8_LDB
#undef PG8_MMA
#undef PG8_WAIT_V
#undef PG8_WAIT_L
#undef PG8_BAR
#undef PG8_SCHED
}

typedef f32x4 Acc[2][2][4][2];

struct EpiProj {
    static constexpr int TSPLIT = -1; static constexpr bool PRE = false;
    bf16_t* PA; bf16_t* GT; const float* bg;
    __device__ __forceinline__ void operator()(const Acc& acc, const Unit& u, int wr, int wc, int fr, int fq) const {
        const bool gate = u.pn >= 22;
        const int row0 = u.pm * BM + wr * 64 + fr, ldc = gate ? GWD : PAW, colt = (gate ? (u.pn - 22) : u.pn) * BM + wc * 32 + 8 * fq;
        bf16_t* base = gate ? GT : PA;
        f32x4 bv[2][2];
#pragma unroll
        for (int bj = 0; bj < 2; ++bj)
#pragma unroll
            for (int n = 0; n < 2; ++n) bv[bj][n] = gate ? *(const f32x4*)(bg + colt + bj * HALF + 4 * n) : (f32x4){0.f, 0.f, 0.f, 0.f};
#pragma unroll
        for (int ai = 0; ai < 2; ++ai)
#pragma unroll
            for (int m = 0; m < 4; ++m) { bf16_t* rowp = base + (size_t)(row0 + ai * HALF + m * 16) * ldc + colt;
#pragma unroll
                for (int bj = 0; bj < 2; ++bj) { f32x4 v0 = acc[ai][bj][m][0] + bv[bj][0], v1 = acc[ai][bj][m][1] + bv[bj][1];
                    if (gate) {
#pragma unroll
                        for (int e = 0; e < 4; ++e) { v0[e] = sigmoidf_(v0[e]); v1[e] = sigmoidf_(v1[e]); } }
                    u32x4 w; w.x = cvt_pk_bf16(v0[0], v0[1]); w.y = cvt_pk_bf16(v0[2], v0[3]); w.z = cvt_pk_bf16(v1[0], v1[1]); w.w = cvt_pk_bf16(v1[2], v1[3]);
                    *(u32x4*)(rowp + bj * HALF) = w; } }
    }
};

struct EpiScale {
    static constexpr int TSPLIT = -1; static constexpr bool PRE = false;
    bf16_t* O; int ldc; const float* sc;
    __device__ __forceinline__ void operator()(const Acc& acc, const Unit& u, int wr, int wc, int fr, int fq) const {
        const int row0 = u.pm * BM + wr * 64 + fr, col0 = u.pn * BM + wc * 32 + 8 * fq;
        f32x4 sv[2][2];
#pragma unroll
        for (int bj = 0; bj < 2; ++bj)
#pragma unroll
            for (int n = 0; n < 2; ++n) sv[bj][n] = *(const f32x4*)(sc + col0 + bj * HALF + 4 * n);
#pragma unroll
        for (int ai = 0; ai < 2; ++ai)
#pragma unroll
            for (int m = 0; m < 4; ++m) { bf16_t* rowp = O + (size_t)(row0 + ai * HALF + m * 16) * ldc + col0;
#pragma unroll
                for (int bj = 0; bj < 2; ++bj) { const f32x4 v0 = acc[ai][bj][m][0] * sv[bj][0], v1 = acc[ai][bj][m][1] * sv[bj][1];
                    u32x4 w; w.x = cvt_pk_bf16(v0[0], v0[1]); w.y = cvt_pk_bf16(v0[2], v0[3]); w.z = cvt_pk_bf16(v1[0], v1[1]); w.w = cvt_pk_bf16(v1[2], v1[3]);
                    *(u32x4*)(rowp + bj * HALF) = w; } }
    }
};

template <bool SECOND> struct EpiGate {
    static constexpr int TSPLIT = -1; static constexpr bool PRE = false;
    const bf16_t* GT; float* T; bf16_t* MX;
    __device__ __forceinline__ void operator()(const Acc& acc, const Unit& u, int wr, int wc, int fr, int fq) const {
        const int row0 = u.pm * BM + wr * 64 + fr, col0 = u.pn * BM + wc * 32 + 8 * fq;
#pragma unroll
        for (int ai = 0; ai < 2; ++ai)
#pragma unroll
            for (int m = 0; m < 4; ++m) { const size_t row = (size_t)(row0 + ai * HALF + m * 16);
#pragma unroll
                for (int bj = 0; bj < 2; ++bj) { const int col = col0 + bj * HALF;
                    const u32x4 gw = *(const u32x4*)(GT + row * GWD + (SECOND ? DM : 0) + col);
                    f32x4 g0 = {bf_lo(gw.x), bf_hi(gw.x), bf_lo(gw.y), bf_hi(gw.y)}, g1 = {bf_lo(gw.z), bf_hi(gw.z), bf_lo(gw.w), bf_hi(gw.w)};
                    f32x4 v0 = acc[ai][bj][m][0] * g0, v1 = acc[ai][bj][m][1] * g1;
                    float* tp = T + row * DM + col;
                    if (!SECOND) { *(f32x4*)tp = v0; *(f32x4*)(tp + 4) = v1; }
                    else { v0 += *(const f32x4*)tp; v1 += *(const f32x4*)(tp + 4);
                        u32x4 w; w.x = cvt_pk_bf16(v0[0], v0[1]); w.y = cvt_pk_bf16(v0[2], v0[3]); w.z = cvt_pk_bf16(v1[0], v1[1]); w.w = cvt_pk_bf16(v1[2], v1[3]);
                        *(u32x4*)(MX + row * DM + col) = w; } } }
    }
};

struct EpiGateCat {
    static constexpr int TSPLIT = 16; static constexpr bool PRE = false;
    const bf16_t* GT; bf16_t* MX;
    __device__ __forceinline__ void mid(Acc& acc, const Unit& u, int wr, int wc, int fr, int fq) const {
        int row0 = u.pm * BM + wr * 64 + fr, col0 = u.pn * BM + wc * 32 + 8 * fq;
        asm volatile("" : "+v"(row0), "+v"(col0));
#pragma unroll
        for (int ai = 0; ai < 2; ++ai) {
            u32x4 ga[4][2], gb[4][2];
#pragma unroll
            for (int m = 0; m < 4; ++m)
#pragma unroll
                for (int bj = 0; bj < 2; ++bj) { const bf16_t* gp = GT + (size_t)(row0 + ai * HALF + m * 16) * GWD + col0 + bj * HALF; ga[m][bj] = *(const u32x4*)gp; gb[m][bj] = *(const u32x4*)(gp + DM); }
#pragma unroll
            for (int m = 0; m < 4; ++m)
#pragma unroll
                for (int bj = 0; bj < 2; ++bj) { const u32x4 a = ga[m][bj], b = gb[m][bj];
                    const f32x4 n0 = {bf_lo(a.x), bf_hi(a.x), bf_lo(a.y), bf_hi(a.y)}, n1 = {bf_lo(a.z), bf_hi(a.z), bf_lo(a.w), bf_hi(a.w)};
                    const f32x4 d0 = {bf_lo(b.x), bf_hi(b.x), bf_lo(b.y), bf_hi(b.y)}, d1 = {bf_lo(b.z), bf_hi(b.z), bf_lo(b.w), bf_hi(b.w)};
                    f32x4 r0, r1;
#pragma unroll
                    for (int e = 0; e < 4; ++e) { r0[e] = n0[e] * __builtin_amdgcn_rcpf(d0[e]); r1[e] = n1[e] * __builtin_amdgcn_rcpf(d1[e]); }
                    acc[ai][bj][m][0] = acc[ai][bj][m][0] * r0; acc[ai][bj][m][1] = acc[ai][bj][m][1] * r1; }
        }
    }
    __device__ __forceinline__ void operator()(const Acc& acc, const Unit& u, int wr, int wc, int fr, int fq) const {
        int row0 = u.pm * BM + wr * 64 + fr, col0 = u.pn * BM + wc * 32 + 8 * fq;
        asm volatile("" : "+v"(row0), "+v"(col0));
        u32x4 gl[2][4][2];
#pragma unroll
        for (int ai = 0; ai < 2; ++ai)
#pragma unroll
            for (int m = 0; m < 4; ++m)
#pragma unroll
                for (int bj = 0; bj < 2; ++bj) gl[ai][m][bj] = *(const u32x4*)(GT + (size_t)(row0 + ai * HALF + m * 16) * GWD + DM + col0 + bj * HALF);
#pragma unroll
        for (int ai = 0; ai < 2; ++ai)
#pragma unroll
            for (int m = 0; m < 4; ++m) { const size_t row = (size_t)(row0 + ai * HALF + m * 16);
#pragma unroll
                for (int bj = 0; bj < 2; ++bj) { const int col = col0 + bj * HALF;
                    const u32x4 b = gl[ai][m][bj];
                    const f32x4 d0 = {bf_lo(b.x), bf_hi(b.x), bf_lo(b.y), bf_hi(b.y)}, d1 = {bf_lo(b.z), bf_hi(b.z), bf_lo(b.w), bf_hi(b.w)};
                    const f32x4 v0 = acc[ai][bj][m][0] * d0, v1 = acc[ai][bj][m][1] * d1;
                    u32x4 w; w.x = cvt_pk_bf16(v0[0], v0[1]); w.y = cvt_pk_bf16(v0[2], v0[3]); w.z = cvt_pk_bf16(v1[0], v1[1]); w.w = cvt_pk_bf16(v1[2], v1[3]);
                    *(u32x4*)(MX + row * DM + col) = w; } }
    }
};

template <bool WRITE_XB> struct EpiResSsq {
    static constexpr int TSPLIT = -1; static constexpr bool PRE = false;
    const float* base; float* out; bf16_t* XB; const float* g; float* ssq; LAS float* red; unsigned* cnt; float* rstd; int wout;
    __device__ __forceinline__ void operator()(const Acc& acc, const Unit& u, int wr, int wc, int fr, int fq) const {
        const int row0 = u.pm * BM + wr * 64 + fr, col0 = u.pn * BM + wc * 32 + 8 * fq;
#pragma unroll
        for (int ai = 0; ai < 2; ++ai) {
            f32x4 bl[4][2][2];
#pragma unroll
            for (int m = 0; m < 4; ++m)
#pragma unroll
                for (int bj = 0; bj < 2; ++bj) { const float* bp = base + (size_t)(row0 + ai * HALF + m * 16) * DM + col0 + bj * HALF; bl[m][bj][0] = *(const f32x4*)bp; bl[m][bj][1] = *(const f32x4*)(bp + 4); }
#pragma unroll
            for (int m = 0; m < 4; ++m) { const size_t row = (size_t)(row0 + ai * HALF + m * 16); float ss = 0.f;
#pragma unroll
                for (int bj = 0; bj < 2; ++bj) { const int col = col0 + bj * HALF;
                    float* op = out + row * DM + col;
                    const f32x4 v0 = bl[m][bj][0] + acc[ai][bj][m][0], v1 = bl[m][bj][1] + acc[ai][bj][m][1];
                    if (!WRITE_XB || wout) { *(f32x4*)op = v0; *(f32x4*)(op + 4) = v1; }
                    ss += (v0[0] * v0[0] + v0[1] * v0[1]) + (v0[2] * v0[2] + v0[3] * v0[3]) + (v1[0] * v1[0] + v1[1] * v1[1]) + (v1[2] * v1[2] + v1[3] * v1[3]);
                    if (WRITE_XB) { const f32x4 a0 = v0, a1 = v1;
                        u32x4 w; w.x = cvt_pk_bf16(a0[0], a0[1]); w.y = cvt_pk_bf16(a0[2], a0[3]); w.z = cvt_pk_bf16(a1[0], a1[1]); w.w = cvt_pk_bf16(a1[2], a1[3]);
                        *(u32x4*)(XB + (row + 2) * DM + col) = w; } }
                ss += __shfl_xor(ss, 16); ss += __shfl_xor(ss, 32);
                if (fq == 0) red[wc * 256 + ai * HALF + wr * 64 + m * 16 + fr] = ss; } }
        __syncthreads();
        const int tid = threadIdx.x;
        if (!WRITE_XB) {
            if (tid < 256) ssq[(size_t)u.pn * SEQ + u.pm * BM + tid] = (red[tid] + red[256 + tid]) + (red[512 + tid] + red[768 + tid]);
            __syncthreads();
        } else {
            if (tid < 256) { const float pv = (red[tid] + red[256 + tid]) + (red[512 + tid] + red[768 + tid]);
                __hip_atomic_store((unsigned*)ssq + (size_t)u.pn * SEQ + u.pm * BM + tid, __builtin_bit_cast(unsigned, pv), __ATOMIC_RELAXED, __HIP_MEMORY_SCOPE_AGENT); }
            asm volatile("s_waitcnt vmcnt(0)" ::: "memory");
            __syncthreads();
            if (tid == 0) { const unsigned old = __hip_atomic_fetch_add(cnt + 64 * u.pm, 1u, __ATOMIC_RELAXED, __HIP_MEMORY_SCOPE_AGENT); ((LAS unsigned*)red)[1024] = (old == 7u) ? 1u : 0u; }
            __syncthreads();
            if (((LAS unsigned*)red)[1024] != 0u && tid < 256) { float sm = 0.f;
#pragma unroll
                for (int p = 0; p < 8; ++p) sm += __builtin_bit_cast(float, __hip_atomic_load((unsigned*)ssq + (size_t)p * SEQ + u.pm * BM + tid, __ATOMIC_RELAXED, __HIP_MEMORY_SCOPE_AGENT));
                rstd[2 + u.pm * BM + tid] = __builtin_amdgcn_rsqf(sm * (1.f / DM) + RMS_EPS); }
            __syncthreads();
        }
    }
};

struct EpiResNorm {
    static constexpr int TSPLIT = -1; static constexpr bool PRE = false;
    float* out; const float* gf; float* ssq; unsigned* cnt; LAS float* red; const bf16_t* XB;
    __device__ __forceinline__ void operator()(Acc& acc, const Unit& u, int wr, int wc, int fr, int fq) const {
        const int row0 = u.pm * BM + wr * 64 + fr, col0 = u.pn * BM + wc * 32 + 8 * fq;
        u32x4 xb[2][4][2];
#pragma unroll
        for (int ai = 0; ai < 2; ++ai)
#pragma unroll
            for (int m = 0; m < 4; ++m)
#pragma unroll
                for (int bj = 0; bj < 2; ++bj) xb[ai][m][bj] = *(const u32x4*)(XB + (size_t)(row0 + ai * HALF + m * 16 + 2) * DM + col0 + bj * HALF);
#pragma unroll
        for (int ai = 0; ai < 2; ++ai)
#pragma unroll
            for (int m = 0; m < 4; ++m) { float ss = 0.f;
#pragma unroll
                for (int bj = 0; bj < 2; ++bj) { const u32x4 w = xb[ai][m][bj];
                    const f32x4 v0 = (f32x4){bf_lo(w.x), bf_hi(w.x), bf_lo(w.y), bf_hi(w.y)} + acc[ai][bj][m][0], v1 = (f32x4){bf_lo(w.z), bf_hi(w.z), bf_lo(w.w), bf_hi(w.w)} + acc[ai][bj][m][1];
                    acc[ai][bj][m][0] = v0; acc[ai][bj][m][1] = v1;
                    ss += (v0[0] * v0[0] + v0[1] * v0[1]) + (v0[2] * v0[2] + v0[3] * v0[3]) + (v1[0] * v1[0] + v1[1] * v1[1]) + (v1[2] * v1[2] + v1[3] * v1[3]); }
                ss += __shfl_xor(ss, 16); ss += __shfl_xor(ss, 32);
                if (fq == 0) red[wc * 256 + ai * HALF + wr * 64 + m * 16 + fr] = ss; }
        __syncthreads();
        const int tid = threadIdx.x;
        if (tid < 256) { const float pv = (red[tid] + red[256 + tid]) + (red[512 + tid] + red[768 + tid]);
            __hip_atomic_store((unsigned*)ssq + (size_t)u.pn * SEQ + u.pm * BM + tid, __builtin_bit_cast(unsigned, pv), __ATOMIC_RELAXED, __HIP_MEMORY_SCOPE_AGENT); }
        asm volatile("s_waitcnt vmcnt(0)" ::: "memory");
        __syncthreads();
        if (tid == 0) { unsigned* c = cnt + 64 * u.pm;
            __hip_atomic_fetch_add(c, 1u, __ATOMIC_RELAXED, __HIP_MEMORY_SCOPE_AGENT);
            unsigned sp = 0; while (__hip_atomic_load(c, __ATOMIC_RELAXED, __HIP_MEMORY_SCOPE_AGENT) < 8u) { __builtin_amdgcn_s_sleep(1); if (++sp > (1u << 22)) break; } }
        __syncthreads();
        if (tid < 256) { float s = 0.f;
#pragma unroll
            for (int p = 0; p < 8; ++p) s += __builtin_bit_cast(float, __hip_atomic_load((unsigned*)ssq + (size_t)p * SEQ + u.pm * BM + tid, __ATOMIC_RELAXED, __HIP_MEMORY_SCOPE_AGENT));
            red[tid] = __builtin_amdgcn_rsqf(s * (1.f / DM) + RMS_EPS); }
        f32x4 gv[2][2];
#pragma unroll
        for (int bj = 0; bj < 2; ++bj)
#pragma unroll
            for (int n = 0; n < 2; ++n) gv[bj][n] = *(const f32x4*)(gf + col0 + bj * HALF + 4 * n);
        __syncthreads();
#pragma unroll
        for (int ai = 0; ai < 2; ++ai)
#pragma unroll
            for (int m = 0; m < 4; ++m) { const size_t row = (size_t)(row0 + ai * HALF + m * 16);
                const float rstd = red[ai * HALF + wr * 64 + m * 16 + fr];
#pragma unroll
                for (int bj = 0; bj < 2; ++bj) { float* op = out + row * DM + col0 + bj * HALF;
                    *(f32x4*)op = acc[ai][bj][m][0] * rstd * gv[bj][0]; *(f32x4*)(op + 4) = acc[ai][bj][m][1] * rstd * gv[bj][1]; } }
        __syncthreads();
    }
};

struct EpiConvGelu {
    static constexpr int TSPLIT = -1; static constexpr bool PRE = true;
    bf16_t* ACT; const float* rstd2; const float* cw; const float* cb; LAS float* prm;
    __device__ __forceinline__ f32x4 pre(const Unit& u) const {
        const int tid = threadIdx.x; f32x4 v = {0.f, 0.f, 0.f, 0.f};
        if (tid < 256) { const int k = tid >> 5, c4 = (tid & 31) * 4, kk = k & 3, chn = ((k >> 2) ? FF : 0) + u.pn * HALF + c4;
            v = *(const f32x4*)((kk < 3 ? cw + (size_t)kk * FF2 : cb) + chn); }
        else if (tid < 320) v = *(const f32x4*)(rstd2 + u.pm * 252 + (tid - 256) * 4);
        return v;
    }
    __device__ __forceinline__ void operator()(const Acc& acc, const Unit& u, int wr, int wc, int fr, int fq, f32x4 epre) const {
        const int tok0 = u.pm * 252 + wr * 126 - 2 + fr * 8;
        { const int tid = threadIdx.x;
          if (tid < 256) *(LAS f32x4*)(prm + (tid >> 5) * 128 + (tid & 31) * 4) = epre;
          else if (tid < 320) *(LAS f32x4*)(prm + 1024 + (tid - 256) * 4) = epre; }
        __syncthreads();
        float r[8];
#pragma unroll
        for (int j = 0; j < 8; ++j) r[j] = prm[1024 + wr * 126 + fr * 8 + j];
        const int cl = wc * 32 + fq * 8;
        const int ch0 = u.pn * HALF + wc * 32 + fq * 8;
        unsigned pk[8][4];
#pragma unroll
        for (int n = 0; n < 2; ++n) {
            const LAS float* pp = prm + cl + 4 * n;
            const f32x4 w0a = *(const LAS f32x4*)(pp), w1a = *(const LAS f32x4*)(pp + 128), w2a = *(const LAS f32x4*)(pp + 256), ba = *(const LAS f32x4*)(pp + 384);
            const f32x4 w0b = *(const LAS f32x4*)(pp + 512), w1b = *(const LAS f32x4*)(pp + 640), w2b = *(const LAS f32x4*)(pp + 768), bb = *(const LAS f32x4*)(pp + 896);
#pragma unroll
            for (int e2 = 0; e2 < 2; ++e2) {
                const f32x2 W0a = {w0a[2 * e2], w0a[2 * e2 + 1]}, W1a = {w1a[2 * e2], w1a[2 * e2 + 1]}, W2a = {w2a[2 * e2], w2a[2 * e2 + 1]}, Ba = {ba[2 * e2], ba[2 * e2 + 1]};
                const f32x2 W0b = {w0b[2 * e2], w0b[2 * e2 + 1]}, W1b = {w1b[2 * e2], w1b[2 * e2 + 1]}, W2b = {w2b[2 * e2], w2b[2 * e2 + 1]}, Bb = {bb[2 * e2], bb[2 * e2 + 1]};
                f32x2 ya[8], yb[8];
#pragma unroll
                for (int j = 0; j < 8; ++j) { const f32x4 va = acc[j >> 2][0][j & 3][n], vb = acc[j >> 2][1][j & 3][n];
                    ya[j] = (f32x2){va[2 * e2], va[2 * e2 + 1]} * r[j]; yb[j] = (f32x2){vb[2 * e2], vb[2 * e2 + 1]} * r[j]; }
                f32x2 am1, am2, bm1, bm2;
                am1.x = __shfl_up(ya[7].x, 1, 16); am1.y = __shfl_up(ya[7].y, 1, 16); am2.x = __shfl_up(ya[6].x, 1, 16); am2.y = __shfl_up(ya[6].y, 1, 16);
                bm1.x = __shfl_up(yb[7].x, 1, 16); bm1.y = __shfl_up(yb[7].y, 1, 16); bm2.x = __shfl_up(yb[6].x, 1, 16); bm2.y = __shfl_up(yb[6].y, 1, 16);
#pragma unroll
                for (int j = 0; j < 8; ++j) {
                    const f32x2 a2 = (j >= 2) ? ya[j >= 2 ? j - 2 : 0] : (j == 1 ? am1 : am2), a1 = (j >= 1) ? ya[j >= 1 ? j - 1 : 0] : am1;
                    const f32x2 b2 = (j >= 2) ? yb[j >= 2 ? j - 2 : 0] : (j == 1 ? bm1 : bm2), b1 = (j >= 1) ? yb[j >= 1 ? j - 1 : 0] : bm1;
                    const f32x2 cva = Ba + W0a * a2 + W1a * a1 + W2a * ya[j];
                    const f32x2 cvb = Bb + W0b * b2 + W1b * b1 + W2b * yb[j];
                    const f32x2 gl = gelu_pk3(cva) * cvb;
                    pk[j][2 * n + e2] = cvt_pk_bf16(gl.x, gl.y); }
            }
        }
#pragma unroll
        for (int j = 0; j < 8; ++j) { const int t = tok0 + j;
            if (t >= 0 && t < SEQ && !(fr == 0 && j < 2)) { u32x4 w; w.x = pk[j][0]; w.y = pk[j][1]; w.z = pk[j][2]; w.w = pk[j][3];
                *(u32x4*)(ACT + (size_t)t * FF + ch0) = w; } }
    }
};
}

__device__ __forceinline__ void transpose_item(const float* __restrict__ W, int N, bf16* WT, int ldt, int dst_row0, LAS float* scr, int k0, int n0, int lane, const float* __restrict__ rs = nullptr) {
    const int r = lane >> 3, c4 = (lane & 7) * 4;
    f32x4 v[8];
#pragma unroll
    for (int i = 0; i < 8; ++i) v[i] = __builtin_nontemporal_load((const f32x4*)(W + (size_t)(k0 + 8 * i + r) * N + n0 + c4));
    if (rs) {
#pragma unroll
        for (int i = 0; i < 8; ++i) v[i] = v[i] * rs[k0 + 8 * i + r]; }
#pragma unroll
    for (int i = 0; i < 8; ++i) { LAS float* d = scr + (8 * i + r) * 33 + c4; d[0] = v[i][0]; d[1] = v[i][1]; d[2] = v[i][2]; d[3] = v[i][3]; }
    LDS_WAIT(); asm volatile("" ::: "memory");
    const int c = lane & 7;
#pragma unroll
    for (int j = 0; j < 4; ++j) { const int n = (lane >> 3) + 8 * j; const LAS float* s = scr + (8 * c) * 33 + n;
        u32x4 o; o.x = cvt_pk_bf16(s[0 * 33], s[1 * 33]); o.y = cvt_pk_bf16(s[2 * 33], s[3 * 33]); o.z = cvt_pk_bf16(s[4 * 33], s[5 * 33]); o.w = cvt_pk_bf16(s[6 * 33], s[7 * 33]);
        *(u32x4*)(WT + (size_t)(dst_row0 + n) * ldt + k0 + 8 * c) = o; }
    LDS_WAIT(); asm volatile("" ::: "memory");
}
template <int MODE>
__device__ __forceinline__ void transpose_matrix(const float* __restrict__ W, int K, int N, bf16* WT, int row_off, LAS float* scr, int gw, int NGW, int lane, int ldt = 0, int koff = 0, const float* __restrict__ rs = nullptr) {
    if (ldt == 0) ldt = K;
    const int nblk = N / 32, nitems = (K / 64) * nblk;
    for (int it = gw; it < nitems; it += NGW) { const int kb = it / nblk, nb = it % nblk, n0 = 32 * nb;
        int d0 = row_off + n0;
        if (MODE == 1) { const int c = n0 < FF ? n0 : n0 - FF; d0 = 256 * (c >> 7) + (c & 127) + (n0 < FF ? 0 : 128); }
        transpose_item(W, N, WT + koff, ldt, d0, scr, 64 * kb, n0, lane, rs); }
}

constexpr int KV_ROWB = 272, KV_BYTES = 256 * KV_ROWB, V_ROWB = 288;
__device__ __forceinline__ void attn_unit(const bf16* PA, bf16* OG, float* LSE, LAS unsigned char* lds, int unit, int tid, int w, int lane) {
    const int g = unit >> 8, rr = unit & 255, h = rr >> 6, c = rr & 63;
    const int dsh = 2 * g, dil = 1 << dsh, nblk = 64 >> dsh, n = c / nblk, b = c % nblk, hg = 4 * g + h;
    const float slope_d = exp2f(-8.f * (float)(hg + 1) / 12.f) * (float)dil;
    const int q = lane >> 4, li = lane & 15, qi = 16 * w + li;
    const size_t tq = (size_t)(128 * b + qi) * dil + n;
    {
        u32x4 v[16];
        const int ch = tid & 15, kk0 = tid >> 4;
#pragma unroll
        for (int it = 0; it < 16; ++it) { const int which = it >> 3, kk = kk0 + 32 * (it & 7), kp = 128 * (b - 1) + kk;
            v[it] = (u32x4){0u, 0u, 0u, 0u};
            if (kp >= 0) { const size_t t = (size_t)kp * dil + n; v[it] = *(const u32x4*)(PA + t * PAW + (which ? OV : OK_) + hg * 128 + ch * 8); } }
#pragma unroll
        for (int it = 0; it < 16; ++it) { const int which = it >> 3, kk = kk0 + 32 * (it & 7);
            *(LAS u32x4*)(lds + which * KV_BYTES + kk * (which ? V_ROWB : KV_ROWB) + ch * 16) = v[it]; }
    }
    bf16x8 qf[4];
#pragma unroll
    for (int s = 0; s < 4; ++s) qf[s] = *(const bf16x8*)(PA + tq * PAW + OQ + hg * 128 + 32 * s + 8 * q);
    __syncthreads();
    f32x4 sc[10];
#pragma unroll
    for (int kt = 0; kt < 10; ++kt) sc[kt] = (f32x4){0.f, 0.f, 0.f, 0.f};
#pragma unroll
    for (int g3 = 0; g3 < 3; ++g3) {
        bf16x8 kf[3][4];
#pragma unroll
        for (int j = 0; j < 3; ++j)
#pragma unroll
            for (int s = 0; s < 4; ++s) kf[j][s] = *(const LAS bf16x8*)(lds + (16 * (w + 3 * g3 + j) + li) * KV_ROWB + 64 * s + 16 * q);
        __builtin_amdgcn_sched_barrier(0);
#pragma unroll
        for (int s = 0; s < 4; ++s)
#pragma unroll
            for (int j = 0; j < 3; ++j) sc[3 * g3 + j] = __builtin_amdgcn_mfma_f32_16x16x32_bf16(kf[j][s], qf[s], sc[3 * g3 + j], 0, 0, 0);
        __builtin_amdgcn_sched_barrier(0);
    }
    const float scale = 0.08838834764831845f;
    float mx = -INFINITY;
#pragma unroll
    for (int kt = 0; kt < 9; ++kt)
#pragma unroll
        for (int e = 0; e < 4; ++e) { const int kk = 16 * (w + kt) + 4 * q + e, j = 128 + qi - kk;
            const bool valid = (j >= 0) && (j <= 128) && (b > 0 || kk >= 128);
            const float sv = valid ? sc[kt][e] * scale - slope_d * (float)j : -INFINITY;
            sc[kt][e] = sv; mx = fmaxf(mx, sv); }
    mx = fmaxf(mx, __shfl_xor(mx, 16)); mx = fmaxf(mx, __shfl_xor(mx, 32));
    float sum = 0.f;
#pragma unroll
    for (int kt = 0; kt < 9; ++kt)
#pragma unroll
        for (int e = 0; e < 4; ++e) { const float p = __expf(sc[kt][e] - mx); sc[kt][e] = p; sum += p; }
    sum += __shfl_xor(sum, 16); sum += __shfl_xor(sum, 32);
    bf16x8 pf[5];
#pragma unroll
    for (int cc = 0; cc < 5; ++cc) { u32x4 wv; wv.x = cvt_pk_bf16(sc[2 * cc][0], sc[2 * cc][1]); wv.y = cvt_pk_bf16(sc[2 * cc][2], sc[2 * cc][3]);
        wv.z = cvt_pk_bf16(sc[2 * cc + 1][0], sc[2 * cc + 1][1]); wv.w = cvt_pk_bf16(sc[2 * cc + 1][2], sc[2 * cc + 1][3]); pf[cc] = __builtin_bit_cast(bf16x8, wv); }
    f32x4 o[8];
#pragma unroll
    for (int nt = 0; nt < 8; ++nt) o[nt] = (f32x4){0.f, 0.f, 0.f, 0.f};
    const LAS unsigned char* vb = lds + KV_BYTES;
#pragma unroll
    for (int cc = 0; cc < 5; ++cc) {
        const int t0 = w + 2 * cc, t1r = w + 2 * cc + 1, t1 = t1r > 15 ? 15 : t1r;
        const int r0 = 16 * t0 + 4 * q + (li >> 2), r1 = 16 * t1 + 4 * q + (li >> 2);
        s16x4 v0[8], v1[8];
#pragma unroll
        for (int nt = 0; nt < 8; ++nt) {
            v0[nt] = __builtin_amdgcn_ds_read_tr16_b64_v4i16((LAS s16x4*)(vb + r0 * V_ROWB + (16 * nt + 4 * (li & 3)) * 2));
            v1[nt] = __builtin_amdgcn_ds_read_tr16_b64_v4i16((LAS s16x4*)(vb + r1 * V_ROWB + (16 * nt + 4 * (li & 3)) * 2)); }
        __builtin_amdgcn_sched_barrier(0);
#pragma unroll
        for (int nt = 0; nt < 8; ++nt) {
            const bf16x8 vf = {v0[nt][0], v0[nt][1], v0[nt][2], v0[nt][3], v1[nt][0], v1[nt][1], v1[nt][2], v1[nt][3]};
            o[nt] = __builtin_amdgcn_mfma_f32_16x16x32_bf16(vf, pf[cc], o[nt], 0, 0, 0); }
        __builtin_amdgcn_sched_barrier(0); }
    const float inv = 1.f / sum;
    bf16* op = OG + ((size_t)g * SEQ + tq) * 512 + h * 128 + 4 * q;
#pragma unroll
    for (int nt = 0; nt < 8; ++nt) { const f32x4 ov = o[nt] * inv; u32x2 w; w.x = cvt_pk_bf16(ov[0], ov[1]); w.y = cvt_pk_bf16(ov[2], ov[3]); *(u32x2*)(op + 16 * nt) = w; }
    if (q == 0) LSE[((size_t)g * SEQ + tq) * 4 + h] = mx + __logf(sum);
    asm volatile("s_waitcnt lgkmcnt(0)\n\ts_barrier" ::: "memory");
}

template <int W>
__device__ __forceinline__ void pool_block(const bf16* PA, bf16* POOLED, int t0, int ch) {
    u32x4 v[W + 7];
#pragma unroll
    for (int r = 0; r < W + 7; ++r) { const int t = t0 - (W - 1) + r; v[r] = (u32x4){0u, 0u, 0u, 0u}; if (t >= 0) v[r] = *(const u32x4*)(PA + (size_t)t * PAW + ch * 8); }
    float s[8];
#pragma unroll
    for (int e = 0; e < 8; ++e) s[e] = 0.f;
#pragma unroll
    for (int r = 0; r < W - 1; ++r) { s[0] += bf_lo(v[r].x); s[1] += bf_hi(v[r].x); s[2] += bf_lo(v[r].y); s[3] += bf_hi(v[r].y); s[4] += bf_lo(v[r].z); s[5] += bf_hi(v[r].z); s[6] += bf_lo(v[r].w); s[7] += bf_hi(v[r].w); }
#pragma unroll
    for (int j = 0; j < 8; ++j) { const u32x4 c = v[j + W - 1];
        const float f[8] = {bf_lo(c.x), bf_hi(c.x), bf_lo(c.y), bf_hi(c.y), bf_lo(c.z), bf_hi(c.z), bf_lo(c.w), bf_hi(c.w)};
#pragma unroll
        for (int e = 0; e < 8; ++e) s[e] += f[e];
        const int t = t0 + j, cnt = (t + 1 < W) ? t + 1 : W; const float ic = 1.f / (float)cnt;
        u32x4 o; o.x = cvt_pk_bf16(s[0] * ic - f[0], s[1] * ic - f[1]); o.y = cvt_pk_bf16(s[2] * ic - f[2], s[3] * ic - f[3]);
        o.z = cvt_pk_bf16(s[4] * ic - f[4], s[5] * ic - f[5]); o.w = cvt_pk_bf16(s[6] * ic - f[6], s[7] * ic - f[7]);
        *(u32x4*)(POOLED + (size_t)t * 1024 + ch * 8) = o;
        const u32x4 d = v[j];
        s[0] -= bf_lo(d.x); s[1] -= bf_hi(d.x); s[2] -= bf_lo(d.y); s[3] -= bf_hi(d.y); s[4] -= bf_lo(d.z); s[5] -= bf_hi(d.z); s[6] -= bf_lo(d.w); s[7] -= bf_hi(d.w); }
}

#define XB_TMO      128
#define XB_XCNT(j)  (256  + 64 * (j))
#define XB_XSUB(j)  (1280 + 64 * (j))
#define XB_XGEN(j)  (2304 + 64 * (j))
#define XB_TOP      3328
#define XB_TOPGEN   3392
#define XCD_BAR_WORDS 3456
#define XB_SPIN_CAP (1u << 18)
__device__ __forceinline__ unsigned xb_ld(unsigned* p)              { return __hip_atomic_load(p, __ATOMIC_RELAXED, __HIP_MEMORY_SCOPE_AGENT); }
__device__ __forceinline__ unsigned xb_add(unsigned* p, unsigned v) { return __hip_atomic_fetch_add(p, v, __ATOMIC_RELAXED, __HIP_MEMORY_SCOPE_AGENT); }
__device__ __forceinline__ unsigned xb_xcc_id() { return (unsigned)__builtin_amdgcn_s_getreg((3 << 11) | 20) & 0xFu; }
#define XB_SPIN(cond, bar) do { unsigned _sp = 0; while (cond) { __builtin_amdgcn_s_sleep(1); \
    if ((++_sp & 255u) == 0u) { if (xb_ld(&(bar)[XB_TMO])) break; if (_sp > XB_SPIN_CAP) { atomicAdd(&(bar)[XB_TMO], 1u); break; } } } } while (0)
struct XcdBarrier { unsigned* bar; unsigned x; volatile LAS unsigned* st; };
__device__ __forceinline__ XcdBarrier xcd_barrier_post(unsigned* bar, volatile LAS unsigned* st) {
    XcdBarrier b; b.bar = bar; b.x = xb_xcc_id(); b.st = st;
    if (threadIdx.x == 0) (void)xb_add(&bar[XB_XCNT(b.x)], 1u);
    return b;
}
__device__ __forceinline__ void xcd_barrier_complete(unsigned* bar, unsigned x, unsigned& nloc, unsigned& nx) {
    const unsigned G = gridDim.x * gridDim.y * gridDim.z;
    unsigned sum, cnt, mine, sp = 0u;
    for (;;) {
        sum = 0u; cnt = 0u; mine = 0u;
#pragma unroll
        for (unsigned j = 0; j < 16; ++j) { const unsigned c = xb_ld(&bar[XB_XCNT(j)]); sum += c; cnt += (c > 0u) ? 1u : 0u; mine = (j == x) ? c : mine; }
        if (sum == G) break;
        __builtin_amdgcn_s_sleep(1);
        if ((++sp & 255u) == 0u) { if (xb_ld(&bar[XB_TMO])) break; if (sp > XB_SPIN_CAP) { atomicAdd(&bar[XB_TMO], 1u); break; } }
    }
    nloc = mine > 0u ? mine : 1u; nx = cnt > 0u ? cnt : 1u;
}
__device__ __forceinline__ void xcd_barrier(const XcdBarrier& b) {
    asm volatile("s_waitcnt vmcnt(0)" ::: "memory");
    __syncthreads();
    if (threadIdx.x == 0) {
        unsigned* bar = b.bar;
        __builtin_amdgcn_s_waitcnt(0);
        unsigned nloc = b.st[0], nx = b.st[1];
        if (nloc == 0u) { xcd_barrier_complete(bar, b.x, nloc, nx); b.st[0] = nloc; b.st[1] = nx; }
        const unsigned old = xb_add(&bar[XB_XSUB(b.x)], 1u);
        const unsigned gen = old / nloc;
        if (old + 1u == (gen + 1u) * nloc) {
            __builtin_amdgcn_fence(__ATOMIC_RELEASE, "agent");
            asm volatile("s_waitcnt vmcnt(0)" ::: "memory");
            const unsigned og = xb_add(&bar[XB_TOP], 1u);
            const unsigned tg = og / nx;
            if (og + 1u == (tg + 1u) * nx) xb_add(&bar[XB_TOPGEN], 1u);
            else XB_SPIN(xb_ld(&bar[XB_TOPGEN]) == tg, bar);
            __builtin_amdgcn_fence(__ATOMIC_ACQUIRE, "agent");
            asm volatile("s_waitcnt vmcnt(0)" ::: "memory");
        } else {
            XB_SPIN(xb_ld(&bar[XB_TOPGEN]) == gen, bar);
            __builtin_amdgcn_fence(__ATOMIC_ACQUIRE, "agent");
            asm volatile("s_waitcnt vmcnt(0)" ::: "memory");
        }
    }
    __syncthreads();
}

struct Args { const float* in[15]; float* out; unsigned char* ws; int ph_lo, ph_hi; };
constexpr int N_PHASES = 9;

__global__ void __launch_bounds__(NT, 2) fwd_megakernel(Args args) {
    extern __shared__ __attribute__((aligned(16))) unsigned char lds_raw[];
    LAS unsigned char* lds = (LAS unsigned char*)lds_raw;
    cg::grid_group grid = cg::this_grid();
    const int tid = threadIdx.x, lane = tid & 63, wave = __builtin_amdgcn_readfirstlane(tid >> 6);
    const int G = gridDim.x, bx = blockIdx.x;
    const int vcu = (G % 8 == 0) ? (bx % 8) * (G / 8) + bx / 8 : bx;
    const int gw = vcu * NWAVES + wave, NGW = G * NWAVES;
    const size_t gt = (size_t)bx * NT + tid, NGT = (size_t)G * NT;
    unsigned char* ws = args.ws;
    const float* x = args.in[0]; const float* g_mix = args.in[1]; const float* w_in = args.in[2]; const float* b_gate = args.in[3];
    const float* w_pool_lin = args.in[4]; const float* pool_scale = args.in[5]; const float* w_pool_out = args.in[6]; const float* w_attn_out = args.in[7];
    const float* w_out = args.in[8]; const float* g_ffn = args.in[9]; const float* w_up = args.in[10]; const float* conv_w = args.in[11];
    const float* conv_b = args.in[12]; const float* w_down = args.in[13]; const float* g_final = args.in[14];
    float* out = args.out;
    float* RSTD1 = (float*)(ws + WS_RSTD);
    float* SSQ1 = (float*)(ws + WS_SSQ1); float* SSQ2 = (float*)(ws + WS_SSQ2); float* LSE = (float*)(ws + WS_LSE);
    bf16* WUP = (bf16*)(ws + WS_WUP); bf16* WDN = (bf16*)(ws + WS_WDN); bf16* WOUT = (bf16*)(ws + WS_WOUT); bf16* WPO = (bf16*)(ws + WS_WPO);
    bf16* WAO = (bf16*)(ws + WS_WAO); bf16* WPL = (bf16*)(ws + WS_WPL); bf16* WIN = (bf16*)(ws + WS_WIN); bf16* H = (bf16*)(ws + WS_H);
    bf16* PA = (bf16*)(ws + WS_PA); bf16* GATES = (bf16*)(ws + WS_GATES); bf16* POOLED = (bf16*)(ws + WS_POOLED); bf16* PM = (bf16*)(ws + WS_PM);
    bf16* AO = (bf16*)(ws + WS_AO); bf16* OG = (bf16*)(ws + WS_OG); float* T = (float*)(ws + WS_T); bf16* MIXED = (bf16*)(ws + WS_MIXED);
    bf16* XB = (bf16*)(ws + WS_XB); bf16* ACT = (bf16*)(ws + WS_ACT);
    const int lo = args.ph_lo, hi = args.ph_hi;
    if (hi > N_PHASES) grid.sync();
    if (tid < 2) ((volatile LAS unsigned*)(lds + BARST_OFF))[tid] = 0u;
    __syncthreads();
    const XcdBarrier xbar = xcd_barrier_post((unsigned*)(ws + WS_BAR), (volatile LAS unsigned*)(lds + BARST_OFF));
#ifndef PH_MASK
#define PH_MASK 0x1ff
#endif
#define IN(k) (((PH_MASK >> (k)) & 1) && lo <= (k) && (k) < hi)
#define SEAM(k) do { if (IN(k) && IN((k) + 1)) { xcd_barrier(xbar); } } while (0)

    if (IN(0)) {
        LAS float* scr = (LAS float*)(lds + wave * 16384);
        transpose_matrix<0>(w_in, DM, INW, WIN, 0, scr, gw, NGW, lane);
        { const f32x4* gr = (const f32x4*)g_mix + lane;
          f32x4 gg[8];
#pragma unroll
          for (int j = 0; j < 8; ++j) gg[j] = gr[64 * j];
          for (int m = gw; m < SEQ; m += 2 * NGW) { const int m2 = m + NGW; const bool has2 = m2 < SEQ;
            const f32x4* xr = (const f32x4*)(x + (size_t)m * DM) + lane; const f32x4* xr2 = (const f32x4*)(x + (size_t)(has2 ? m2 : m) * DM) + lane;
            f32x4 v[8], v2[8]; float s = 0.f, s2 = 0.f;
#pragma unroll
            for (int j = 0; j < 8; ++j) { v[j] = __builtin_nontemporal_load(xr + 64 * j); v2[j] = __builtin_nontemporal_load(xr2 + 64 * j); }
#pragma unroll
            for (int j = 0; j < 8; ++j) { s += (v[j].x * v[j].x + v[j].y * v[j].y) + (v[j].z * v[j].z + v[j].w * v[j].w); s2 += (v2[j].x * v2[j].x + v2[j].y * v2[j].y) + (v2[j].z * v2[j].z + v2[j].w * v2[j].w); }
            const float rstd = __builtin_amdgcn_rsqf(wave_sum(s) * (1.f / DM) + RMS_EPS), rstd2 = __builtin_amdgcn_rsqf(wave_sum(s2) * (1.f / DM) + RMS_EPS);
            u32x2* o8 = (u32x2*)(H + (size_t)m * DM) + lane; u32x2* o82 = (u32x2*)(H + (size_t)(has2 ? m2 : m) * DM) + lane;
#pragma unroll
            for (int j = 0; j < 8; ++j) { u32x2 o; o.x = cvt_pk_bf16(v[j].x * rstd * gg[j].x, v[j].y * rstd * gg[j].y); o.y = cvt_pk_bf16(v[j].z * rstd * gg[j].z, v[j].w * rstd * gg[j].w); o8[64 * j] = o; }
            if (has2) {
#pragma unroll
              for (int j = 0; j < 8; ++j) { u32x2 o; o.x = cvt_pk_bf16(v2[j].x * rstd2 * gg[j].x, v2[j].y * rstd2 * gg[j].y); o.y = cvt_pk_bf16(v2[j].z * rstd2 * gg[j].z, v2[j].w * rstd2 * gg[j].w); o82[64 * j] = o; } }
          } }
        __syncthreads();
    }
    SEAM(0);

    if (IN(1)) {
        pg8::Gemm g{H, WIN, DM, DM, DM, 0}; pg8::StaticOrder S; S.init(SEQ / 256, INW / 256, G, bx);
        pg8::EpiProj E{PA, GATES, b_gate};
        pg8::gemm_phase<pg8::EpiProj, false>(lds, g, S, E);
        LAS float* scr = (LAS float*)(lds + wave * 16384);
        { const int nu = (SEQ / 256) * (INW / 256), rounds = (nu + G - 1) / G, busy = nu - (rounds - 1) * G, nidle = G - busy;
          const bool all = (nidle < 16); const int cgw = all ? gw : (bx - busy) * NWAVES + wave, cngw = all ? NGW : nidle * NWAVES;
          if (all || bx >= busy) {
            for (int gi = 0; gi < 4; ++gi) transpose_matrix<0>(w_pool_lin + (size_t)gi * 65536, 256, 256, WPL, 256 * gi, scr, cgw, cngw, lane);
            transpose_matrix<0>(w_pool_out, 1024, DM, WPO, 0, scr, cgw, cngw, lane, 1536, 0);
            transpose_matrix<0>(w_attn_out, 512, DM, WPO, 0, scr, cgw, cngw, lane, 1536, 1024);
            transpose_matrix<0>(w_out, DM, DM, WOUT, 0, scr, cgw, cngw, lane); } }
    }
    SEAM(1);

    if (IN(2)) {
        for (int u = bx; u < 768; u += G) attn_unit(PA, OG, LSE, lds, u, tid, wave, lane);
        for (size_t idx = gt; idx < (size_t)SEQ * 16; idx += NGT) { const int c32 = (int)(idx & 31), t0 = 8 * (int)((idx >> 5) & 1023), gi = (int)(idx >> 15);
            if (gi == 0) pool_block<2>(PA, POOLED, t0, c32); else if (gi == 1) pool_block<4>(PA, POOLED, t0, 32 + c32);
            else if (gi == 2) pool_block<8>(PA, POOLED, t0, 64 + c32); else pool_block<16>(PA, POOLED, t0, 96 + c32); }
    }
    SEAM(2);

    if (IN(3)) {
        const int p3u = (SEQ / 256) * 4; const bool p3split = (G >= p3u + 64);
        const size_t cgt = p3split ? (size_t)(bx - p3u) * NT + tid : gt, cngt = p3split ? (size_t)(G - p3u) * NT : NGT;
        if (!p3split || bx >= p3u)
        for (size_t base = cgt; base < (size_t)SEQ * 64; base += 4 * cngt) {
            float l[4][3]; u32x4 a[4][3];
#pragma unroll
            for (int k = 0; k < 4; ++k) { const size_t idx = base + (size_t)k * cngt; const bool ok = idx < (size_t)SEQ * 64; const size_t t = ok ? (idx >> 6) : 0; const int c8 = (int)(idx & 63), hd = c8 >> 4;
#pragma unroll
                for (int gq = 0; gq < 3; ++gq) { l[k][gq] = LSE[((size_t)gq * SEQ + t) * 4 + hd]; a[k][gq] = *(const u32x4*)(OG + ((size_t)gq * SEQ + t) * 512 + c8 * 8); } }
#pragma unroll
            for (int k = 0; k < 4; ++k) { const size_t idx = base + (size_t)k * cngt; if (idx >= (size_t)SEQ * 64) continue; const size_t t = idx >> 6; const int c8 = (int)(idx & 63);
                const float m = fmaxf(l[k][0], fmaxf(l[k][1], l[k][2])); const float e0 = __expf(l[k][0] - m), e1 = __expf(l[k][1] - m), e2 = __expf(l[k][2] - m); const float is = 1.f / (e0 + e1 + e2);
                const float w0 = e0 * is, w1 = e1 * is, w2 = e2 * is;
                u32x4 o;
#pragma unroll
                for (int p = 0; p < 4; ++p) { const unsigned x0 = a[k][0][p], x1 = a[k][1][p], x2 = a[k][2][p];
                    o[p] = cvt_pk_bf16(bf_lo(x0) * w0 + bf_lo(x1) * w1 + bf_lo(x2) * w2, bf_hi(x0) * w0 + bf_hi(x1) * w1 + bf_hi(x2) * w2); }
                *(u32x4*)(PM + t * 1536 + 1024 + c8 * 8) = o; } }
        pg8::Gemm g{POOLED, WPL, 1024, 256, 256, 512}; pg8::StaticOrder S; S.init(SEQ / 256, 4, G, bx);
        pg8::EpiScale E{PM, 1536, pool_scale};
        pg8::gemm_phase<pg8::EpiScale, false>(lds, g, S, E);
    }
    SEAM(3);

    if (IN(4)) {
        pg8::StaticOrder S; S.init(SEQ / 256, DM / 256, G, bx);
        { pg8::Gemm g{PM, WPO, 1536, 1536, 1536, 0}; pg8::EpiGateCat E{GATES, MIXED}; pg8::gemm_phase<pg8::EpiGateCat, false>(lds, g, S, E); }
    }
    SEAM(4);

    if (IN(5)) {
        pg8::Gemm g{MIXED, WOUT, DM, DM, DM, 0}; pg8::StaticOrder S; S.init(SEQ / 256, DM / 256, G, bx);
        if (bx == 0) { for (int i = tid; i < 2 * DM / 2; i += NT) ((unsigned*)XB)[i] = 0u;
            if (tid < 2) RSTD1[tid] = 0.f; if (tid < XB_ROWS - SEQ - 2) RSTD1[SEQ + 2 + tid] = 0.f; }
        pg8::EpiResSsq<true> E{x, out, XB, g_ffn, SSQ1, (LAS float*)(lds + RED_OFF), (unsigned*)(ws + WS_BAR) + XCD_BAR_WORDS + 34 * 64, RSTD1, (G >= 256) ? 0 : 1};
        pg8::gemm_phase<pg8::EpiResSsq<true>, false>(lds, g, S, E);
        LAS float* scr = (LAS float*)(lds + wave * 16384);
        transpose_matrix<1>(w_up, DM, FF2, WUP, 0, scr, gw, NGW, lane, 0, 0, g_ffn);
    }
    SEAM(5);

    if (IN(6)) {
        pg8::Gemm g{XB, WUP, DM, DM, DM, 0}; pg8::StaticOrder S; S.init(33, FF2 / 256, G, bx);
        pg8::EpiConvGelu E{ACT, RSTD1, conv_w, conv_b, (LAS float*)(lds + RED_OFF)};
        pg8::gemm_phase<pg8::EpiConvGelu, true>(lds, g, S, E);
        LAS float* scr = (LAS float*)(lds + wave * 16384);
        { const int nu = 33 * (FF2 / 256), rounds = (nu + G - 1) / G, busy = nu - (rounds - 1) * G, nidle = G - busy;
          const bool all = (nidle < 16); const int cgw = all ? gw : (bx - busy) * NWAVES + wave, cngw = all ? NGW : nidle * NWAVES;
          if (all || bx >= busy) transpose_matrix<0>(w_down, FF, DM, WDN, 0, scr, cgw, cngw, lane); }
    }
    SEAM(6);

    const bool fuse_norm = (G >= 256);
    if (IN(7)) {
        pg8::Gemm g{ACT, WDN, FF, FF, FF, 0}; pg8::StaticOrder S; S.init(SEQ / 256, DM / 256, G, bx);
        if (fuse_norm) { pg8::EpiResNorm E{out, g_final, SSQ2, (unsigned*)(ws + WS_BAR) + XCD_BAR_WORDS, (LAS float*)(lds + RED_OFF), XB};
            pg8::gemm_phase<pg8::EpiResNorm, false>(lds, g, S, E); }
        else { pg8::EpiResSsq<false> E{out, out, nullptr, nullptr, SSQ2, (LAS float*)(lds + RED_OFF), nullptr, nullptr, 1};
            pg8::gemm_phase<pg8::EpiResSsq<false>, false>(lds, g, S, E); }
    }
    if (!fuse_norm) SEAM(7);

    if (IN(8) && !fuse_norm) {
        for (int m = gw; m < SEQ; m += NGW) {
            float s = 0.f;
#pragma unroll
            for (int p = 0; p < 8; ++p) s += SSQ2[p * SEQ + m];
            const float rstd = __builtin_amdgcn_rsqf(s * (1.f / DM) + RMS_EPS);
            f32x4* xr = (f32x4*)(out + (size_t)m * DM) + lane; const f32x4* gr = (const f32x4*)g_final + lane;
#pragma unroll
            for (int j = 0; j < 8; ++j) { const f32x4 v = xr[64 * j], gg = gr[64 * j]; xr[64 * j] = v * rstd * gg; }
        }
    }
#undef IN
#undef SEAM
}

extern "C" void kernel_launch(void* const* d_in, const int* in_sizes, int n_in, void* d_out, int out_size, void* d_ws, size_t ws_size, hipStream_t stream) {
    static int grid = 0;
    if (grid == 0) {
        if (n_in != 15 || in_sizes[0] != SEQ * DM || out_size != SEQ * DM || ws_size < WS_END) {
            fprintf(stderr, "kernel_launch: unexpected shapes (n_in %d, in0 %d, out %d, ws %zu; need ws >= %zu)\n", n_in, n_in > 0 ? in_sizes[0] : -1, out_size, ws_size, (size_t)WS_END); grid = -1; return; }
        int dev = 0, cus = 0, per_cu = 0;
        if (hipGetDevice(&dev) != hipSuccess || hipDeviceGetAttribute(&cus, hipDeviceAttributeMultiprocessorCount, dev) != hipSuccess) { grid = -1; return; }
        if (hipFuncSetAttribute((const void*)fwd_megakernel, hipFuncAttributeMaxDynamicSharedMemorySize, LDS_BYTES) != hipSuccess) { fprintf(stderr, "kernel_launch: hipFuncSetAttribute failed\n"); grid = -1; return; }
        if (hipOccupancyMaxActiveBlocksPerMultiprocessor(&per_cu, (const void*)fwd_megakernel, NT, LDS_BYTES) != hipSuccess || per_cu < 1) { fprintf(stderr, "kernel_launch: occupancy query says %d\n", per_cu); per_cu = 1; }
        (void)hipGetLastError();
        grid = cus;
    }
    if (grid < 0) return;
    if (hipMemsetAsync((char*)d_ws + WS_BAR, 0, (XCD_BAR_WORDS + 66 * 64) * 4, stream) != hipSuccess) { fprintf(stderr, "kernel_launch: memset failed\n"); return; }
    Args a{};
    for (int i = 0; i < 15; ++i) a.in[i] = (const float*)d_in[i];
    a.out = (float*)d_out; a.ws = (unsigned char*)d_ws; a.ph_lo = 0; a.ph_hi = N_PHASES;
    void* kargs[] = {&a};
#ifdef PROBE_LO
    a.ph_lo = PROBE_LO; a.ph_hi = PROBE_HI;
    (void)hipLaunchCooperativeKernel((const void*)fwd_megakernel, dim3(grid), dim3(NT), kargs, LDS_BYTES, stream);
    a.ph_lo = 0; a.ph_hi = N_PHASES;
    (void)hipMemsetAsync((char*)d_ws + WS_BAR, 0, (XCD_BAR_WORDS + 66 * 64) * 4, stream);
#endif
    hipError_t e = hipLaunchCooperativeKernel((const void*)fwd_megakernel, dim3(grid), dim3(NT), kargs, LDS_BYTES, stream);
#ifdef PROBE_AFTER_LO
    a.ph_lo = PROBE_AFTER_LO; a.ph_hi = PROBE_AFTER_HI;
    (void)hipLaunchCooperativeKernel((const void*)fwd_megakernel, dim3(grid), dim3(NT), kargs, LDS_BYTES, stream);
#endif
    if (e != hipSuccess) fprintf(stderr, "kernel_launch: cooperative launch failed: %s (grid %d)\n", hipGetErrorString(e), grid);
}
```
